# Optimizing an MI355X kernel written in HIP

```python
import math
import jax, jax.numpy as jnp
from jax import lax
import numpy as np

D_MODEL = 1024
BATCH = 8
SEQ = 2048
DEPTH = 4
DEC_BATCH = 128
DEC_SEQ = 4
PAST_LEN = 16384
PAGE_SIZE = 128

N_META = 16
MIX_WIDTH = D_MODEL
D_A = MIX_WIDTH // 2
D_B = MIX_WIDTH - D_A
HG_HEADS = 4
HG_DK = 128
HG_DV = D_A // HG_HEADS
S5_GROUP = 16
S5_GROUPS = D_B // S5_GROUP
S5_STATE = 64
FFN_DIM = 2816
CHUNK = 64
EPS = 1e-6
N_QK = HG_HEADS * HG_DK
IN_COLS = 2 * N_QK + 2 * D_A + D_B
F32 = jnp.float32

kernel_name = 'hymba_hgrn2_s5_macaron_step'


def rmsnorm(x, g):
    xf = x.astype(F32)
    y = xf * lax.rsqrt(jnp.mean(xf * xf, axis=-1, keepdims=True) + EPS)
    return (y * g.astype(F32)).astype(x.dtype)


def swiglu(x, w_gate, w_up, w_down):
    return (jax.nn.silu(x @ w_gate) * (x @ w_up)) @ w_down


def hgrn2_recurrence(q, log_f, k, v, s0, chunk, lead_pad):
    if lead_pad > 0:
        pad = ((0, 0), (lead_pad, 0), (0, 0), (0, 0))
        q, log_f, k, v = (jnp.pad(t, pad) for t in (q, log_f, k, v))
    bsz, length, heads, _ = q.shape
    dv = v.shape[-1]
    n_blocks = length // chunk

    def to_blocks(t):
        return t.reshape(bsz, n_blocks, chunk, heads, t.shape[-1]).transpose(1, 0, 3, 2, 4)

    causal = jnp.tril(jnp.ones((chunk, chunk), dtype=bool))[:, :, None]

    def step(state, blk):
        qc, gc, kc, vc = blk
        b = jnp.cumsum(gc, axis=2)
        o_inter = jnp.einsum('bhtk,bhkv->bhtv', qc * jnp.exp(b), state)
        diff = b[:, :, :, None, :] - b[:, :, None, :, :]
        decay = jnp.exp(jnp.where(causal, diff, -jnp.inf))
        scores = jnp.einsum('bhtk,bhsk,bhtsk->bhts', qc, kc, decay)
        o_intra = jnp.einsum('bhts,bhsv->bhtv', scores, vc)
        b_last = b[:, :, -1:, :]
        state = (jnp.exp(b_last[:, :, 0, :, None]) * state
                 + jnp.einsum('bhsk,bhsv->bhkv', kc * jnp.exp(b_last - b), vc))
        return state, o_inter + o_intra

    s_fin, o = lax.scan(step, s0, (to_blocks(q), to_blocks(log_f), to_blocks(k), to_blocks(v)))
    o = o.transpose(1, 0, 3, 2, 4).reshape(bsz, length, heads, dv)
    return o[:, lead_pad:], s_fin


def _complex_affine_combine(e1, e2):
    a1r, a1i, b1r, b1i = e1
    a2r, a2i, b2r, b2i = e2
    return (a2r * a1r - a2i * a1i, a2r * a1i + a2i * a1r,
            a2r * b1r - a2i * b1i + b2r, a2r * b1i + a2i * b1r + b2i)


def s5_ssm(u, lam_re, lam_im, log_dt, b_re, b_im, c_re, c_im, d_skip, x0_re, x0_im):
    dt = jnp.exp(log_dt.astype(F32))[:, None]
    lr = jnp.minimum(lam_re.astype(F32), -1e-4)
    li = lam_im.astype(F32)
    mag = jnp.exp(lr * dt)
    ar, ai = mag * jnp.cos(li * dt), mag * jnp.sin(li * dt)
    den = lr * lr + li * li
    cr = ((ar - 1.0) * lr + ai * li) / den
    ci = (ai * lr - (ar - 1.0) * li) / den
    br, bi = b_re.astype(F32), b_im.astype(F32)
    bbr = cr[..., None] * br - ci[..., None] * bi
    bbi = cr[..., None] * bi + ci[..., None] * br
    bu_r = jnp.einsum('blgh,gph->blgp', u, bbr)
    bu_i = jnp.einsum('blgh,gph->blgp', u, bbi)
    bu_r = jnp.concatenate([x0_r[:, None] if False else x0_re.astype(F32)[:, None], bu_r], axis=1)
    bu_i = jnp.concatenate([x0_im.astype(F32)[:, None], bu_i], axis=1)
    a_r = jnp.broadcast_to(ar, bu_r.shape)
    a_i = jnp.broadcast_to(ai, bu_i.shape)
    _, _, xr, xi = lax.associative_scan(_complex_affine_combine, (a_r, a_i, bu_r, bu_i), axis=1)
    xr, xi = xr[:, 1:], xi[:, 1:]
    y = (jnp.einsum('blgp,ghp->blgh', xr, c_re.astype(F32))
         - jnp.einsum('blgp,ghp->blgh', xi, c_im.astype(F32))
         + d_skip.astype(F32) * u)
    return y, xr[:, -1], xi[:, -1]


def mixer(hn, l, params, lb, s_hg, s_re, s_im, chunk, lead_pad):
    (_, _, _, _, _, _, w_in, hgrn_norm, s5_lambda_re, s5_lambda_im, s5_log_dt, s5_b_re, s5_b_im,
     s5_c_re, s5_c_im, s5_d, s5_w_glu, s5_b_glu, s5_norm, w_out, _, _, _, _, _) = params
    bsz, length, _ = hn.shape
    z = hn @ w_in[l]
    zq, zf, zi, zg, zu = jnp.split(z.astype(F32), [N_QK, 2 * N_QK, 2 * N_QK + D_A, 2 * N_QK + 2 * D_A], axis=-1)
    q = jax.nn.silu(zq).reshape(bsz, length, HG_HEADS, HG_DK)
    log_f = jnp.logaddexp(jnp.log(lb), jnp.log1p(-lb) + jax.nn.log_sigmoid(zf))
    k = (1.0 - lb) * jax.nn.sigmoid(-zf)
    log_f = log_f.reshape(bsz, length, HG_HEADS, HG_DK)
    k = k.reshape(bsz, length, HG_HEADS, HG_DK)
    v = zi.reshape(bsz, length, HG_HEADS, HG_DV)
    o_hg, s_hg_new = hgrn2_recurrence(q, log_f, k, v, s_hg.astype(F32), chunk, lead_pad)
    o_hg = rmsnorm(o_hg, hgrn_norm[l].reshape(HG_HEADS, HG_DV)).reshape(bsz, length, D_A) * jax.nn.silu(zg)
    u = zu.reshape(bsz, length, S5_GROUPS, S5_GROUP)
    y, s_re_new, s_im_new = s5_ssm(u, s5_lambda_re[l], s5_lambda_im[l], s5_log_dt[l], s5_b_re[l], s5_b_im[l],
                                   s5_c_re[l], s5_c_im[l], s5_d[l], s_re, s_im)
    y = jax.nn.gelu(y.reshape(bsz, length, D_B))
    y = y * jax.nn.sigmoid(y @ s5_w_glu[l].astype(F32) + s5_b_glu[l].astype(F32))
    y = rmsnorm(y, s5_norm[l])
    out = jnp.concatenate([o_hg, y], axis=-1).astype(hn.dtype) @ w_out[l]
    return out.astype(hn.dtype), s_hg_new, s_re_new, s_im_new


def layer_stack(h, s_hg, s_re, s_im, params, chunk, lead_pad):
    (lb_param, norm_ffn1, ffn1_w_gate, ffn1_w_up, ffn1_w_down, norm_mix, _, _, _, _, _, _, _, _, _, _, _, _, _, _,
     norm_ffn2, ffn2_w_gate, ffn2_w_up, ffn2_w_down, norm_final) = params
    lb_all = jnp.cumsum(jax.nn.softmax(lb_param.astype(F32), axis=0), axis=0)
    lb_all = lb_all - lb_all[0:1]
    new_hg, new_re, new_im = [], [], []
    for l in range(DEPTH):
        h = h + 0.5 * swiglu(rmsnorm(h, norm_ffn1[l]), ffn1_w_gate[l], ffn1_w_up[l], ffn1_w_down[l])
        m, a, b, c = mixer(rmsnorm(h, norm_mix[l]), l, params, lb_all[l], s_hg[l], s_re[l], s_im[l], chunk, lead_pad)
        h = h + m
        h = h + 0.5 * swiglu(rmsnorm(h, norm_ffn2[l]), ffn2_w_gate[l], ffn2_w_up[l], ffn2_w_down[l])
        new_hg.append(a)
        new_re.append(b)
        new_im.append(c)
    return rmsnorm(h, norm_final), jnp.stack(new_hg), jnp.stack(new_re), jnp.stack(new_im)


def setup_inputs(seed: int = 0) -> dict:
    key = jax.random.key(seed)
    ks = iter(jax.random.split(key, 40))
    nrm = lambda shape, scale: scale * jax.random.normal(next(ks), shape, F32)
    gain = lambda shape: 1.0 + nrm(shape, 0.02)
    lam_im_base = jnp.broadcast_to(math.pi * jnp.arange(S5_STATE, dtype=F32), (DEPTH, S5_GROUPS, S5_STATE))
    return {
        'x_prompt': nrm((BATCH, SEQ, D_MODEL), 1.0),
        'x_sample': nrm((DEC_BATCH, DEC_SEQ, D_MODEL), 1.0),
        'state_hgrn': nrm((DEPTH, DEC_BATCH, HG_HEADS, HG_DK, HG_DV), 0.5),
        'state_s5_re': nrm((DEPTH, DEC_BATCH, S5_GROUPS, S5_STATE), 0.1),
        'state_s5_im': nrm((DEPTH, DEC_BATCH, S5_GROUPS, S5_STATE), 0.1),
        'meta_tokens': nrm((N_META, D_MODEL), 1.0),
        'lb_param': nrm((DEPTH, N_QK), 0.1),
        'norm_ffn1': gain((DEPTH, D_MODEL)),
        'ffn1_w_gate': nrm((DEPTH, D_MODEL, FFN_DIM), D_MODEL ** -0.5),
        'ffn1_w_up': nrm((DEPTH, D_MODEL, FFN_DIM), D_MODEL ** -0.5),
        'ffn1_w_down': nrm((DEPTH, FFN_DIM, D_MODEL), FFN_DIM ** -0.5),
        'norm_mix': gain((DEPTH, D_MODEL)),
        'w_in': nrm((DEPTH, D_MODEL, IN_COLS), D_MODEL ** -0.5),
        'hgrn_norm': gain((DEPTH, D_A)),
        's5_lambda_re': -0.5 + nrm((DEPTH, S5_GROUPS, S5_STATE), 0.01),
        's5_lambda_im': lam_im_base + nrm((DEPTH, S5_GROUPS, S5_STATE), 0.01),
        's5_log_dt': jax.random.uniform(next(ks), (DEPTH, S5_GROUPS), F32, math.log(1e-3), math.log(1e-1)),
        's5_b_re': nrm((DEPTH, S5_GROUPS, S5_STATE, S5_GROUP), S5_GROUP ** -0.5),
        's5_b_im': nrm((DEPTH, S5_GROUPS, S5_STATE, S5_GROUP), S5_GROUP ** -0.5),
        's5_c_re': nrm((DEPTH, S5_GROUPS, S5_GROUP, S5_STATE), S5_STATE ** -0.5),
        's5_c_im': nrm((DEPTH, S5_GROUPS, S5_GROUP, S5_STATE), S5_STATE ** -0.5),
        's5_d': nrm((DEPTH, S5_GROUPS, S5_GROUP), 1.0),
        's5_w_glu': nrm((DEPTH, D_B, D_B), D_B ** -0.5),
        's5_b_glu': nrm((DEPTH, D_B), 0.01),
        's5_norm': gain((DEPTH, D_B)),
        'w_out': nrm((DEPTH, MIX_WIDTH, D_MODEL), MIX_WIDTH ** -0.5),
        'norm_ffn2': gain((DEPTH, D_MODEL)),
        'ffn2_w_gate': nrm((DEPTH, D_MODEL, FFN_DIM), D_MODEL ** -0.5),
        'ffn2_w_up': nrm((DEPTH, D_MODEL, FFN_DIM), D_MODEL ** -0.5),
        'ffn2_w_down': nrm((DEPTH, FFN_DIM, D_MODEL), FFN_DIM ** -0.5),
        'norm_final': gain((D_MODEL,)),
    }


def reference(x_prompt, x_sample, state_hgrn, state_s5_re, state_s5_im, meta_tokens, lb_param,
              norm_ffn1, ffn1_w_gate, ffn1_w_up, ffn1_w_down, norm_mix, w_in, hgrn_norm,
              s5_lambda_re, s5_lambda_im, s5_log_dt, s5_b_re, s5_b_im, s5_c_re, s5_c_im, s5_d,
              s5_w_glu, s5_b_glu, s5_norm, w_out, norm_ffn2, ffn2_w_gate, ffn2_w_up, ffn2_w_down,
              norm_final):
    params = (lb_param, norm_ffn1, ffn1_w_gate, ffn1_w_up, ffn1_w_down, norm_mix, w_in, hgrn_norm,
              s5_lambda_re, s5_lambda_im, s5_log_dt, s5_b_re, s5_b_im, s5_c_re, s5_c_im, s5_d,
              s5_w_glu, s5_b_glu, s5_norm, w_out, norm_ffn2, ffn2_w_gate, ffn2_w_up, ffn2_w_down,
              norm_final)
    bsz = x_prompt.shape[0]
    meta = jnp.broadcast_to(meta_tokens.astype(x_prompt.dtype)[None], (bsz, N_META, D_MODEL))
    h_prompt = jnp.concatenate([meta, x_prompt], axis=1)
    zero_hg = jnp.zeros((DEPTH, bsz, HG_HEADS, HG_DK, HG_DV), F32)
    zero_s5 = jnp.zeros((DEPTH, bsz, S5_GROUPS, S5_STATE), F32)
    y_p, hgrn_prompt, s5_re_prompt, s5_im_prompt = layer_stack(
        h_prompt, zero_hg, zero_s5, zero_s5, params, CHUNK, CHUNK - N_META)
    y_prompt = y_p[:, N_META:]
    y_sample, hgrn_sample, s5_re_sample, s5_im_sample = layer_stack(
        x_sample, state_hgrn, state_s5_re, state_s5_im, params, x_sample.shape[1], 0)
    return (y_prompt, y_sample, hgrn_prompt, s5_re_prompt, s5_im_prompt, hgrn_sample, s5_re_sample, s5_im_sample)
```

```cpp
#include <hip/hip_runtime.h>
#include <hip/hip_cooperative_groups.h>
#include <cstdio>
namespace cg = cooperative_groups;

#define LAS __attribute__((address_space(3)))
typedef unsigned short bf16_t;
typedef short bf16x8 __attribute__((ext_vector_type(8)));
typedef short bf16x4 __attribute__((ext_vector_type(4)));
typedef float f32x4 __attribute__((ext_vector_type(4)));
typedef float f32x2 __attribute__((ext_vector_type(2)));
typedef unsigned u32x4 __attribute__((ext_vector_type(4)));
typedef unsigned u32x2 __attribute__((ext_vector_type(2)));

constexpr int D = 1024, NB = 8, SEQ = 2048, LP = 2064, MPROMPT = NB * LP, M = 17024, MPAD = 17152;
constexpr int DEPTH = 4, FFN = 2816, FFN2 = 5632, INC = 2560;
constexpr float EPS = 1e-6f;
constexpr int NTHREADS = 512;
constexpr int LDS_BYTES = 131072;
#ifndef EN_MASK
#define EN_MASK 0x3F
#endif
#define EN(k) ((EN_MASK >> (k)) & 1)
#ifndef DOWN_SPLIT
#define DOWN_SPLIT 4
#endif
#ifndef KREP_UP
#define KREP_UP 1
#endif
#ifndef DUP_SLOT
#define DUP_SLOT -1
#endif

constexpr size_t O_YP = 0, O_YS = 16777216, O_HGP = O_YS + 524288, O_S5RP = O_HGP + 2097152, O_S5IP = O_S5RP + 65536,
                 O_HGS = O_S5IP + 65536, O_S5RS = O_HGS + 33554432, O_S5IS = O_S5RS + 1048576;

constexpr size_t SZ_WA = (size_t)FFN2 * D * 2, SZ_WD = (size_t)D * FFN * 2, SZ_WIN = (size_t)INC * D * 2, SZ_WGLU = 512 * 512 * 2, SZ_WOUT = (size_t)D * D * 2;
constexpr size_t WL_A1 = 0, WL_D1 = WL_A1 + SZ_WA, WL_A2 = WL_D1 + SZ_WD, WL_D2 = WL_A2 + SZ_WA, WL_IN = WL_D2 + SZ_WD, WL_GLU = WL_IN + SZ_WIN,
                 WL_OUT = WL_GLU + SZ_WGLU, WL_SZ = WL_OUT + SZ_WOUT;
constexpr size_t WS_W = 0;
constexpr size_t WS_H32 = WS_W + 4 * WL_SZ;
constexpr size_t WS_HB = WS_H32 + (size_t)MPAD * D * 4;
constexpr size_t WS_SS = WS_HB + (size_t)MPAD * D * 2;
constexpr size_t WS_LB = WS_SS + (size_t)17 * MPAD * 16 * 4;
constexpr size_t WS_ABAR = WS_LB + 8192;
constexpr size_t WS_BBT = WS_ABAR + 65536;
constexpr size_t WS_CT = WS_BBT + 524288;
constexpr size_t WS_MIX = WS_CT + 524288;
constexpr size_t R512 = (size_t)MPAD * 512 * 2;
constexpr size_t WS_QT = WS_MIX, WS_KT = WS_QT + R512, WS_KTT = WS_KT + R512, WS_VT = WS_KTT + R512, WS_GS = WS_VT + R512, WS_UB = WS_GS + R512,
                 WS_YG = WS_UB + R512, WS_ORAW = WS_YG + R512, WS_MIXIN = WS_ORAW + 2 * R512, WS_ADEC = WS_MIXIN + 2 * R512,
                 WS_ADECS = WS_ADEC + (size_t)(MPAD / 16) * 512 * 4, WS_BAR = WS_ADECS + 128 * 512 * 4, WS_PART = WS_BAR + 8192, WS_END = WS_PART + (size_t)12 * 4 * 256 * 256 * 4;
constexpr size_t WS_ACT = WS_MIX;
static_assert((size_t)MPAD * FFN * 2 <= WS_BAR - WS_MIX, "act alias");

struct Params { const float* in[31]; float* out; unsigned char* ws; };
typedef const __attribute__((address_space(4))) Params* KP;
__device__ __forceinline__ KP kargs() { KP q = (KP)__builtin_amdgcn_kernarg_segment_ptr(); asm volatile("" : "+s"(q)); return q; }
#define GAS __attribute__((address_space(1)))
template <class T> __device__ __forceinline__ T* as_global(T* q) { return (T*)(GAS T*)q; }
__device__ __forceinline__ unsigned char* launder(unsigned char* q) { GAS unsigned char* g = (GAS unsigned char*)q; asm volatile("" : "+s"(g)); return (unsigned char*)g; }
__device__ __forceinline__ const float* gin(int i) { return as_global(kargs()->in[i]); }
__device__ __forceinline__ float* gout() { return as_global(kargs()->out); }
__device__ __forceinline__ unsigned char* gws() { return as_global(kargs()->ws); }

typedef __bf16 bf16v2 __attribute__((ext_vector_type(2)));
__device__ __forceinline__ unsigned pk_bf16(float lo, float hi) { f32x2 v = {lo, hi}; bf16v2 b = __builtin_convertvector(v, bf16v2); return __builtin_bit_cast(unsigned, b); }
__device__ __forceinline__ bf16_t to_bf16(float x) { return (bf16_t)(pk_bf16(x, 0.f) & 0xffffu); }
__device__ __forceinline__ float bf16_lo(unsigned w) { return __uint_as_float(w << 16); }
__device__ __forceinline__ float bf16_hi(unsigned w) { return __uint_as_float(w & 0xffff0000u); }
__device__ __forceinline__ float frcp(float x) { return __builtin_amdgcn_rcpf(x); }
__device__ __forceinline__ float sigm(float x) { return frcp(1.f + __expf(-x)); }
__device__ __forceinline__ float silu(float x) { return x * sigm(x); }
__device__ __forceinline__ float gelu_tanh(float x) { return x * sigm(1.5957691216057308f * (x + 0.044715f * x * x * x)); }
template <int N> __device__ __forceinline__ float dpp_shr(float x) { return __int_as_float(__builtin_amdgcn_update_dpp(0, __float_as_int(x), 0x110 + N, 0xF, 0xF, true)); }
__device__ __forceinline__ float scan16(float x, bool sample, int fr) {
    float t = dpp_shr<1>(x); if (sample && (fr & 3) < 1) t = 0.f; x += t;
    t = dpp_shr<2>(x); if (sample && (fr & 3) < 2) t = 0.f; x += t;
    if (!sample) { x += dpp_shr<4>(x); x += dpp_shr<8>(x); }
    return x;
}
__device__ __forceinline__ f32x4 mfma32(bf16x8 a, bf16x8 b, f32x4 c) { return __builtin_amdgcn_mfma_f32_16x16x32_bf16(a, b, c, 0, 0, 0); }
__device__ __forceinline__ f32x4 mfma16(bf16x4 a, bf16x4 b, f32x4 c) {
    const bf16x8 a8 = (bf16x8){a[0], a[1], a[2], a[3], 0, 0, 0, 0}, b8 = (bf16x8){b[0], b[1], b[2], b[3], 0, 0, 0, 0};
    return __builtin_amdgcn_mfma_f32_16x16x32_bf16(a8, b8, c, 0, 0, 0);
}
__device__ __forceinline__ float row_ss16(const float* base, int row) {
    const f32x4* q = (const f32x4*)(base + (size_t)row * 16);
    const f32x4 a = q[0], b = q[1], c = q[2], d = q[3];
    return ((a[0] + a[1]) + (a[2] + a[3])) + ((b[0] + b[1]) + (b[2] + b[3])) + ((c[0] + c[1]) + (c[2] + c[3])) + ((d[0] + d[1]) + (d[2] + d[3]));
}
__device__ __forceinline__ float row_ss8(const float* base, int row) {
    const f32x4* q = (const f32x4*)(base + (size_t)row * 16);
    const f32x4 a = q[0], b = q[1];
    return ((a[0] + a[1]) + (a[2] + a[3])) + ((b[0] + b[1]) + (b[2] + b[3]));
}
#define MFMA_FENCE() do { __builtin_amdgcn_sched_barrier(0); asm volatile("s_nop 15\n\ts_nop 15" ::: "memory"); __builtin_amdgcn_sched_barrier(0); } while (0)
#define LGKM0() asm volatile("s_waitcnt lgkmcnt(0)" ::: "memory")

namespace pg8 {
constexpr int BM = 256, BK = 64, HALF = 128, HTB = HALF * BK * 2, STAGE_BYTES = 8 * HTB, NXCD = 8, WGM = 8;
__device__ __forceinline__ int lds_byte(int r, int c) { const int st = (r >> 4) * 2 + (c >> 5), rr = r & 15, cc = c & 31, ob = rr * 64 + cc * 2; return st * 1024 + (ob ^ (((ob >> 9) & 1) << 5)); }
__device__ __forceinline__ void stage_rc(int b, int& R, int& C) { const int st = b / 1024, sb = b % 1024, swz = sb ^ (((sb >> 9) & 1) << 5); R = (st >> 1) * 16 + swz / 64; C = (st & 1) * 32 + (swz % 64) / 2; }

struct Unit { int pm, pn, kh, skip, k0, nt, part; };
struct Gemm { const bf16_t* A; const bf16_t* Bt; int lda, ldb, K; };
struct Order {
    int nM, nN, nwg, G, c, ks, rep, K, nsplit;
    __device__ void init(int nM_, int nN_, int G_, int c_, int ks_, int K_, int rep_ = 1, int nsplit_ = 0) { nM = nM_; nN = nN_; nwg = nM * nN; G = G_; c = c_; ks = ks_; rep = rep_; K = K_; nsplit = nsplit_; }
    __device__ void tile_of(int L, int& pm, int& pn) const {
        int wgid = L; { const int q = nwg / NXCD, r = nwg % NXCD, xcd = wgid % NXCD, off = wgid / NXCD; wgid = (xcd < r ? xcd * (q + 1) : r * (q + 1) + (xcd - r) * q) + off; }
        const int nig = WGM * nN, gid = wgid / nig, fm = gid * WGM, gsz = (nM - fm) < WGM ? (nM - fm) : WGM;
        pm = fm + ((wgid % nig) % gsz); pn = (wgid % nig) / gsz;
    }
    __device__ bool next(int i0, Unit& u) const {
        const int i = i0 / rep; u.skip = (i0 - i * rep) != rep - 1;
        if (nsplit > 0 && i >= ks) {
            if (i > ks) return false;
            const int L = G + c / nsplit; if (L >= nwg) return false;
            const int part = c - (c / nsplit) * nsplit, ntall = ks * K / BK;
            const int base = (ntall / nsplit) & ~1, extra = (ntall - base * nsplit) / 2;
            u.part = part; u.kh = c / nsplit; u.nt = base + (part < extra ? 2 : 0);
            u.k0 = (part * base + 2 * (part < extra ? part : extra)) * BK;
            tile_of(L, u.pm, u.pn); return true;
        }
        const int t = i / ks; u.kh = i - t * ks; u.part = -1; u.k0 = u.kh * K; u.nt = K / BK;
        const long L = (long)t * G + c; if (L >= nwg) return false;
        tile_of((int)L, u.pm, u.pn); return true;
    }
};

template <class Epi>
__device__ __forceinline__ void gemm_phase(LAS unsigned char* lds, const Gemm g, const Order& S, const Epi& E, int tid) {
    asm volatile("" : "+v"(tid));
    const int wid = __builtin_amdgcn_readfirstlane(tid >> 6), lane = tid & 63, wr = wid >> 2, wc = wid & 3, fr = lane & 15, fq = lane >> 4;
    unsigned voffA[2], voffB[2];
#pragma unroll
    for (int i = 0; i < 2; ++i) { int R, C; stage_rc(tid * 16 + i * 8192, R, C); voffA[i] = (unsigned)(R * g.lda + C) * 2u; voffB[i] = (unsigned)(R * g.ldb + C) * 2u; }
    const size_t kstep = (size_t)(BK * 2);
    const size_t hstepA = (size_t)HALF * g.lda * 2, hstepB = (size_t)HALF * g.ldb * 2;
    const size_t tstepA = 2 * hstepA, tstepB = 2 * hstepB;
    const unsigned ldsw = (unsigned)wid * 1024u;
    const int aoff = lds_byte(wr * 64 + fr, fq * 8), boff = lds_byte(wc * 32 + fr, fq * 8);
#define PG8_SA(b, h) (((b) * 2 + (h)) * HTB)
#define PG8_SB(b, h) ((4 + (b) * 2 + (h)) * HTB)
#define PG8_STAGE(bufoff, gbase, voff) do { _Pragma("unroll") for (int _i = 0; _i < 2; ++_i) \
        __builtin_amdgcn_global_load_lds((const unsigned*)((const char*)(gbase) + (voff)[_i]), (LAS unsigned*)(lds + (bufoff) + ldsw + _i * 8192), 16, 0, 0); } while (0)
#define PG8_LDA(dst, b, h) do { _Pragma("unroll") for (int m = 0; m < 4; ++m) _Pragma("unroll") for (int k = 0; k < 2; ++k) dst[m][k] = *(const LAS bf16x8*)(lds + PG8_SA(b, h) + aoff + m * 2048 + k * 1024); } while (0)
#define PG8_LDB(dst, b, h) do { _Pragma("unroll") for (int n = 0; n < 2; ++n) _Pragma("unroll") for (int k = 0; k < 2; ++k) dst[n][k] = *(const LAS bf16x8*)(lds + PG8_SB(b, h) + boff + n * 2048 + k * 1024); } while (0)
#define PG8_MMA(ai, bj, At, Bt) do { __builtin_amdgcn_s_setprio(1); _Pragma("unroll") for (int m = 0; m < 4; ++m) _Pragma("unroll") for (int n = 0; n < 2; ++n) _Pragma("unroll") for (int k = 0; k < 2; ++k) \
        acc[ai][bj][m][n] = __builtin_amdgcn_mfma_f32_16x16x32_bf16(Bt[n][k], At[m][k], acc[ai][bj][m][n], 0, 0, 0); __builtin_amdgcn_s_setprio(0); } while (0)
#define PG8_WAIT_V(n) asm volatile("s_waitcnt vmcnt(" #n ")" ::: "memory")
#define PG8_WAIT_L(n) asm volatile("s_waitcnt lgkmcnt(" #n ")" ::: "memory")
#define PG8_BAR __builtin_amdgcn_s_barrier()
#define PG8_SCHED __builtin_amdgcn_sched_barrier(0)
    Unit cur, nxt; int ui = 0;
    if (!S.next(0, cur)) return;
    f32x4 acc[2][2][4][2];
#pragma unroll
    for (int a = 0; a < 2; ++a)
#pragma unroll
        for (int b = 0; b < 2; ++b)
#pragma unroll
            for (int m = 0; m < 4; ++m)
#pragma unroll
                for (int n = 0; n < 2; ++n) acc[a][b][m][n] = (f32x4){0.f, 0.f, 0.f, 0.f};
    bf16x8 At[4][2], B0[2][2], B1[2][2];
    const char* cA = (const char*)g.A + (size_t)cur.pm * tstepA + (size_t)cur.k0 * 2;
    const char* cB = (const char*)g.Bt + (size_t)cur.pn * tstepB + (size_t)cur.k0 * 2;
    PG8_STAGE(PG8_SB(0, 0), cB, voffB); PG8_STAGE(PG8_SA(0, 0), cA, voffA); PG8_STAGE(PG8_SB(0, 1), cB + hstepB, voffB); PG8_STAGE(PG8_SA(0, 1), cA + hstepA, voffA);
    if (wr == 1) PG8_BAR;
    PG8_WAIT_V(4); PG8_BAR;
    PG8_STAGE(PG8_SB(1, 0), cB + kstep, voffB); PG8_STAGE(PG8_SA(1, 0), cA + kstep, voffA); PG8_STAGE(PG8_SB(1, 1), cB + hstepB + kstep, voffB);
    PG8_WAIT_V(6); PG8_BAR;
    for (;;) {
        const bool has_next = S.next(ui + 1, nxt);
        const char* nA = has_next ? (const char*)g.A + (size_t)nxt.pm * tstepA + (size_t)nxt.k0 * 2 : cA;
        const char* nB = has_next ? (const char*)g.Bt + (size_t)nxt.pn * tstepB + (size_t)nxt.k0 * 2 : cB;
        const int nt = cur.nt;
        for (int t = 0; t < nt; t += 2) {
            const bool last = (t == nt - 2);
            const char* a1 = cA + (size_t)(t + 1) * kstep;
            const char* a2 = last ? nA : cA + (size_t)(t + 2) * kstep; const char* b2 = last ? nB : cB + (size_t)(t + 2) * kstep;
            const char* a3 = a2 + kstep; const char* b3 = b2 + kstep;
            PG8_LDB(B0, 0, 0); PG8_SCHED; PG8_LDA(At, 0, 0); PG8_STAGE(PG8_SA(1, 1), a1 + hstepA, voffA);
            PG8_WAIT_L(8); PG8_BAR; PG8_WAIT_L(0); PG8_MMA(0, 0, At, B0); PG8_BAR; PG8_SCHED;
            PG8_LDB(B1, 0, 1); PG8_STAGE(PG8_SB(0, 0), b2, voffB);
            PG8_BAR; PG8_WAIT_L(0); PG8_MMA(0, 1, At, B1); PG8_BAR;
            PG8_LDA(At, 0, 1); PG8_STAGE(PG8_SA(0, 0), a2, voffA);
            PG8_BAR; PG8_WAIT_L(0); PG8_MMA(1, 0, At, B0); PG8_BAR; PG8_SCHED;
            PG8_STAGE(PG8_SB(0, 1), b2 + hstepB, voffB);
            PG8_WAIT_V(6); PG8_BAR; PG8_MMA(1, 1, At, B1); PG8_BAR;
            PG8_LDB(B0, 1, 0); PG8_SCHED; PG8_LDA(At, 1, 0); PG8_STAGE(PG8_SA(0, 1), a2 + hstepA, voffA);
            PG8_WAIT_L(8); PG8_BAR; PG8_WAIT_L(0); PG8_MMA(0, 0, At, B0); PG8_BAR; PG8_SCHED;
            PG8_LDB(B1, 1, 1); PG8_STAGE(PG8_SB(1, 0), b3, voffB);
            PG8_BAR; PG8_WAIT_L(0); PG8_MMA(0, 1, At, B1); PG8_BAR;
            PG8_LDA(At, 1, 1); PG8_STAGE(PG8_SA(1, 0), a3, voffA);
            PG8_BAR; PG8_WAIT_L(0); PG8_MMA(1, 0, At, B0); PG8_BAR; PG8_SCHED;
            PG8_STAGE(PG8_SB(1, 1), b3 + hstepB, voffB);
            PG8_WAIT_V(6); PG8_BAR; PG8_MMA(1, 1, At, B1); PG8_BAR;
        }
        MFMA_FENCE();
        if (!cur.skip) E(acc, cur, wr, wc, fr, fq);
        if (!has_next) break;
#pragma unroll
        for (int a = 0; a < 2; ++a)
#pragma unroll
            for (int b = 0; b < 2; ++b)
#pragma unroll
                for (int m = 0; m < 4; ++m)
#pragma unroll
                    for (int n = 0; n < 2; ++n) acc[a][b][m][n] = (f32x4){0.f, 0.f, 0.f, 0.f};
        cur = nxt; cA = nA; cB = nB; ++ui;
    }
    PG8_WAIT_V(0);
    if (wr == 0) PG8_BAR;
    PG8_BAR;
#undef PG8_SA
#undef PG8_SB
#undef PG8_STAGE
#undef PG8_LDA
#undef PG8_LDB
#undef PG8_MMA
#undef PG8_WAIT_V
#undef PG8_WAIT_L
#undef PG8_BAR
#undef PG8_SCHED
}
}
using pg8::Unit;

__device__ __forceinline__ void row_rstd8(float (&rs)[2][4], const float* ss, int rbase, int fq, int nslot4, float inv_n) {
    f32x4 p[2][4];
#pragma unroll
    for (int ai = 0; ai < 2; ++ai)
#pragma unroll
        for (int m = 0; m < 4; ++m) {
            p[ai][m] = (f32x4){0.f, 0.f, 0.f, 0.f};
            if (fq < nslot4) p[ai][m] = *(const f32x4*)(ss + (size_t)(rbase + ai * 128 + m * 16) * 16 + 4 * fq);
        }
#pragma unroll
    for (int ai = 0; ai < 2; ++ai)
#pragma unroll
        for (int m = 0; m < 4; ++m) {
            float t = (p[ai][m][0] + p[ai][m][1]) + (p[ai][m][2] + p[ai][m][3]);
            t += __shfl_xor(t, 16); t += __shfl_xor(t, 32);
            rs[ai][m] = rsqrtf(t * inv_n + EPS);
        }
}

struct EpiSwiglu {
    unsigned char* ws0; int ssi;
    __device__ __forceinline__ void operator()(const f32x4 (&acc)[2][2][4][2], const Unit& u, int wr, int wc, int fr, int fq) const {
        unsigned char* ws = launder(ws0);
        const float* ss = (const float*)(ws + WS_SS) + (size_t)ssi * MPAD * 16; bf16_t* act = (bf16_t*)(ws + WS_ACT);
        const int rbase = u.pm * 256 + wr * 64 + fr;
        float rsv[2][4]; row_rstd8(rsv, ss, rbase, fq, 4, 1.f / 1024.f);
#pragma unroll
        for (int ai = 0; ai < 2; ++ai)
#pragma unroll
            for (int m = 0; m < 4; ++m) {
                const int row = rbase + ai * 128 + m * 16;
                const float rs = rsv[ai][m];
#pragma unroll
                for (int bj = 0; bj < 2; ++bj) {
                    const f32x4 gv = acc[ai][bj][m][0] * rs, uv = acc[ai][bj][m][1] * rs;
                    const int oc = u.pn * 128 + bj * 64 + wc * 16 + 4 * fq;
                    u32x2 w; w.x = pk_bf16(silu(gv[0]) * uv[0], silu(gv[1]) * uv[1]); w.y = pk_bf16(silu(gv[2]) * uv[2], silu(gv[3]) * uv[3]);
                    *(u32x2*)(act + (size_t)row * FFN + oc) = w;
                }
            }
    }
};

struct EpiRes {
    unsigned char* ws0; int ssni, ss5i; float scale;
    __device__ __forceinline__ void operator()(const f32x4 (&acc)[2][2][4][2], const Unit& u, int wr, int wc, int fr, int fq) const {
        unsigned char* ws = launder(ws0);
        float* h32 = (float*)(ws + WS_H32); bf16_t* hb = (bf16_t*)(ws + WS_HB); float* ssn = (float*)(ws + WS_SS) + (size_t)ssni * MPAD * 16;
        const int rbase = u.pm * 256 + wr * 64 + fr;
        if (u.part >= 0) {
            int lo = (wr * 64 + fr) * 256 + wc * 32 + 4 * fq; asm volatile("" : "+v"(lo));
            float* pb = (float*)(ws + WS_PART) + (size_t)(u.kh * 4 + u.part) * 65536 + lo;
#pragma unroll
            for (int ai = 0; ai < 2; ++ai)
#pragma unroll
                for (int m = 0; m < 4; ++m)
#pragma unroll
                    for (int bj = 0; bj < 2; ++bj)
#pragma unroll
                        for (int n = 0; n < 2; ++n)
                            *(f32x4*)(pb + (ai * 128 + m * 16) * 256 + bj * 128 + n * 16) = acc[ai][bj][m][n] * scale;
            return;
        }
        const bool partial = (ss5i >= 0) && (u.kh == 0);
        float rsv[2][4];
        if (ss5i >= 0 && u.kh == 1) row_rstd8(rsv, (const float*)(ws + WS_SS) + (size_t)ss5i * MPAD * 16, rbase, fq, 2, 1.f / 512.f);
        else {
#pragma unroll
            for (int ai = 0; ai < 2; ++ai)
#pragma unroll
                for (int m = 0; m < 4; ++m) rsv[ai][m] = scale;
        }
#pragma unroll
        for (int ai = 0; ai < 2; ++ai) {
            f32x4 hv[4][2][2];
#pragma unroll
            for (int m = 0; m < 4; ++m)
#pragma unroll
                for (int bj = 0; bj < 2; ++bj)
#pragma unroll
                    for (int n = 0; n < 2; ++n)
                        hv[m][bj][n] = *(const f32x4*)(h32 + (size_t)(rbase + ai * 128 + m * 16) * D + u.pn * 256 + bj * 128 + wc * 32 + n * 16 + 4 * fq);
#pragma unroll
            for (int m = 0; m < 4; ++m) {
                const int row = rbase + ai * 128 + m * 16;
                const float sc = rsv[ai][m];
                float s = 0.f;
#pragma unroll
                for (int bj = 0; bj < 2; ++bj)
#pragma unroll
                    for (int n = 0; n < 2; ++n) {
                        const int c = u.pn * 256 + bj * 128 + wc * 32 + n * 16 + 4 * fq;
                        const f32x4 hn = hv[m][bj][n] + acc[ai][bj][m][n] * sc;
                        *(f32x4*)(h32 + (size_t)row * D + c) = hn;
                        if (!partial) {
                            u32x2 w; w.x = pk_bf16(hn[0], hn[1]); w.y = pk_bf16(hn[2], hn[3]);
                            *(u32x2*)(hb + (size_t)row * D + c) = w;
                            s += hn[0] * hn[0] + hn[1] * hn[1] + hn[2] * hn[2] + hn[3] * hn[3];
                        }
                    }
                if (!partial) {
                    s += __shfl_xor(s, 16); s += __shfl_xor(s, 32);
                    if (fq == 0) ssn[(size_t)row * 16 + u.pn * 4 + wc] = s;
                }
            }
        }
    }
};

struct EpiWin {
    unsigned char* ws0; int l;
    __device__ __forceinline__ void operator()(const f32x4 (&acc)[2][2][4][2], const Unit& u, int wr, int wc, int fr, int fq) const {
        unsigned char* ws = launder(ws0);
        const float* ss = (const float*)(ws + WS_SS) + (size_t)(3 * l + 1) * MPAD * 16; const float* lb = (const float*)(ws + WS_LB) + l * 512;
        bf16_t *qt = (bf16_t*)(ws + WS_QT), *kt = (bf16_t*)(ws + WS_KT), *ktT = (bf16_t*)(ws + WS_KTT), *vT = (bf16_t*)(ws + WS_VT), *gs = (bf16_t*)(ws + WS_GS), *ub = (bf16_t*)(ws + WS_UB);
        float *adec = (float*)(ws + WS_ADEC), *adecS = (float*)(ws + WS_ADECS);
        const int rbase = u.pm * 256 + wr * 64 + fr;
        float rsv[2][4]; row_rstd8(rsv, ss, rbase, fq, 4, 1.f / 1024.f);
        f32x4 lbv2[2];
#pragma unroll
        for (int bj = 0; bj < 2; ++bj) lbv2[bj] = *(const f32x4*)(lb + (u.pn & 3) * 128 + bj * 64 + wc * 16 + 4 * fq);
#pragma unroll
        for (int ai = 0; ai < 2; ++ai)
#pragma unroll
            for (int m = 0; m < 4; ++m) {
                const int row = rbase + ai * 128 + m * 16;
                const float rs = rsv[ai][m];
                const bool sample = (row - fr) >= MPROMPT;
                const size_t tb = (size_t)(row >> 4) * 512 * 16 + (row & 15);
                if (u.pn < 4) {
#pragma unroll
                    for (int bj = 0; bj < 2; ++bj) {
                        const int c0 = u.pn * 128 + bj * 64 + wc * 16 + 4 * fq;
                        const f32x4 lbv = lbv2[bj];
                        const f32x4 zq = acc[ai][bj][m][0] * rs, zf = acc[ai][bj][m][1] * rs;
                        f32x4 qv, kv, av;
#pragma unroll
                        for (int e = 0; e < 4; ++e) {
                            const float q = silu(zq[e]);
                            const float sg = sigm(zf[e]);
                            const float f = lbv[e] + (1.f - lbv[e]) * sg;
                            const float lf = __logf(fmaxf(f, 1e-30f));
                            const float kk = (1.f - lbv[e]) * (1.f - sg);
                            const float b = scan16(lf, sample, fr);
                            qv[e] = q * __expf(b); kv[e] = kk * __expf(fminf(-b, 80.f)); av[e] = __expf(b);
                        }
                        u32x2 w; w.x = pk_bf16(qv[0], qv[1]); w.y = pk_bf16(qv[2], qv[3]);
                        *(u32x2*)(qt + (size_t)row * 512 + c0) = w;
                        w.x = pk_bf16(kv[0], kv[1]); w.y = pk_bf16(kv[2], kv[3]);
                        *(u32x2*)(kt + (size_t)row * 512 + c0) = w;
#pragma unroll
                        for (int e = 0; e < 4; ++e) ktT[tb + (size_t)(c0 + e) * 16] = to_bf16(kv[e]);
                        if (!sample) { if (fr == 15 && row < MPROMPT) *(f32x4*)(adec + (size_t)(row >> 4) * 512 + c0) = av; }
                        else { if ((fr & 3) == 3 && row < M) *(f32x4*)(adecS + (size_t)((row - MPROMPT) >> 2) * 512 + c0) = av; }
                    }
                } else {
#pragma unroll
                    for (int bj = 0; bj < 2; ++bj)
#pragma unroll
                        for (int n = 0; n < 2; ++n) {
                            const int c = (u.pn & 1) * 256 + bj * 128 + wc * 32 + n * 16 + 4 * fq;
                            const f32x4 v = acc[ai][bj][m][n] * rs;
                            if (u.pn < 6) {
#pragma unroll
                                for (int e = 0; e < 4; ++e) vT[tb + (size_t)(c + e) * 16] = to_bf16(v[e]);
                            } else if (u.pn < 8) {
                                u32x2 w; w.x = pk_bf16(silu(v[0]), silu(v[1])); w.y = pk_bf16(silu(v[2]), silu(v[3]));
                                *(u32x2*)(gs + (size_t)row * 512 + c) = w;
                            } else {
                                u32x2 w; w.x = pk_bf16(v[0], v[1]); w.y = pk_bf16(v[2], v[3]);
                                *(u32x2*)(ub + (size_t)row * 512 + c) = w;
                            }
                        }
                }
            }
    }
};

struct EpiGlu {
    unsigned char* ws0; int l;
    __device__ __forceinline__ void operator()(const f32x4 (&acc)[2][2][4][2], const Unit& u, int wr, int wc, int fr, int fq) const {
        unsigned char* ws = launder(ws0);
        const bf16_t* yg = (const bf16_t*)(ws + WS_YG); const float* bias = gin(23) + l * 512; bf16_t* mixin = (bf16_t*)(ws + WS_MIXIN);
        float* ss5 = (float*)(ws + WS_SS) + (size_t)(13 + l) * MPAD * 16;
        const int rbase = u.pm * 256 + wr * 64 + fr;
        f32x4 bv[2][2];
#pragma unroll
        for (int bj = 0; bj < 2; ++bj)
#pragma unroll
            for (int n = 0; n < 2; ++n) bv[bj][n] = *(const f32x4*)(bias + u.pn * 256 + bj * 128 + wc * 32 + n * 16 + 4 * fq);
#pragma unroll
        for (int ai = 0; ai < 2; ++ai) {
            u32x2 yw[4][2][2];
#pragma unroll
            for (int m = 0; m < 4; ++m)
#pragma unroll
                for (int bj = 0; bj < 2; ++bj)
#pragma unroll
                    for (int n = 0; n < 2; ++n)
                        yw[m][bj][n] = *(const u32x2*)(yg + (size_t)(rbase + ai * 128 + m * 16) * 512 + u.pn * 256 + bj * 128 + wc * 32 + n * 16 + 4 * fq);
#pragma unroll
            for (int m = 0; m < 4; ++m) {
                const int row = rbase + ai * 128 + m * 16;
                float s = 0.f;
#pragma unroll
                for (int bj = 0; bj < 2; ++bj)
#pragma unroll
                    for (int n = 0; n < 2; ++n) {
                        const int c = u.pn * 256 + bj * 128 + wc * 32 + n * 16 + 4 * fq;
                        const f32x4 a = acc[ai][bj][m][n] + bv[bj][n];
                        const u32x2 y2 = yw[m][bj][n];
                        f32x4 o;
                        o[0] = bf16_lo(y2.x) * sigm(a[0]); o[1] = bf16_hi(y2.x) * sigm(a[1]); o[2] = bf16_lo(y2.y) * sigm(a[2]); o[3] = bf16_hi(y2.y) * sigm(a[3]);
                        u32x2 w; w.x = pk_bf16(o[0], o[1]); w.y = pk_bf16(o[2], o[3]);
                        *(u32x2*)(mixin + (size_t)row * 1024 + 512 + c) = w;
                        s += o[0] * o[0] + o[1] * o[1] + o[2] * o[2] + o[3] * o[3];
                    }
                s += __shfl_xor(s, 16); s += __shfl_xor(s, 32);
                if (fq == 0) ss5[(size_t)row * 16 + u.pn * 4 + wc] = s;
            }
        }
    }
};

__device__ __forceinline__ void convert_tile(int t, LAS float* tile, int tid) {
    KP p = kargs(); (void)p;
    const int l = t / 2592; int r = t - l * 2592;
    const float *s0 = nullptr, *s1 = nullptr, *gn = nullptr, *gn2 = nullptr; int K, Nsrc, mode; size_t doff;
    if (r < 704) { mode = 0; s0 = gin(8) + (size_t)l * D * FFN; s1 = gin(9) + (size_t)l * D * FFN; gn = gin(7) + l * D; K = D; Nsrc = FFN; doff = WL_A1; }
    else if ((r -= 704) < 352) { mode = 1; s0 = gin(10) + (size_t)l * FFN * D; K = FFN; Nsrc = D; doff = WL_D1; }
    else if ((r -= 352) < 704) { mode = 0; s0 = gin(27) + (size_t)l * D * FFN; s1 = gin(28) + (size_t)l * D * FFN; gn = gin(26) + l * D; K = D; Nsrc = FFN; doff = WL_A2; }
    else if ((r -= 704) < 352) { mode = 1; s0 = gin(29) + (size_t)l * FFN * D; K = FFN; Nsrc = D; doff = WL_D2; }
    else if ((r -= 352) < 320) { mode = 2; s0 = gin(12) + (size_t)l * D * INC; gn = gin(11) + l * D; K = D; Nsrc = INC; doff = WL_IN; }
    else if ((r -= 320) < 32) { mode = 1; s0 = gin(22) + (size_t)l * 512 * 512; K = 512; Nsrc = 512; doff = WL_GLU; }
    else { r -= 32; mode = 3; s0 = gin(25) + (size_t)l * D * D; gn = gin(13) + l * 512; gn2 = gin(24) + l * 512; K = D; Nsrc = D; doff = WL_OUT; }
    bf16_t* dst = (bf16_t*)(gws() + WS_W + (size_t)l * WL_SZ + doff);
    const int nkt = K / 128, ntile = r / nkt, kt = r - ntile * nkt, n0 = ntile * 64, k0 = kt * 128;
    const int rr = tid & 63, np = n0 + rr;
    const float* src = s0; int col = np;
    if (mode == 0) { const int j = np >> 5, half = (np >> 4) & 1; col = 16 * j + (np & 15); src = half ? s1 : s0; }
    else if (mode == 2 && np < 1024) { const int j = np >> 5, half = (np >> 4) & 1, c = 16 * j + (np & 15); col = half ? 512 + c : c; }
    float v[16];
#pragma unroll
    for (int it = 0; it < 16; ++it) v[it] = src[(size_t)(k0 + (tid >> 6) + 8 * it) * Nsrc + col];
#pragma unroll
    for (int it = 0; it < 16; ++it) {
        const int kk = (tid >> 6) + 8 * it, k = k0 + kk;
        float x = v[it];
        if (mode == 0 || mode == 2) x *= gn[k];
        else if (mode == 3) x *= (k < 512 ? gn[k] : gn2[k - 512]);
        tile[kk * 65 + rr] = x;
    }
    __syncthreads();
    { const int r2 = tid >> 3, kc = tid & 7; float f[16];
#pragma unroll
      for (int j = 0; j < 16; ++j) f[j] = tile[(kc * 16 + j) * 65 + r2];
      u32x4 w0, w1; w0.x = pk_bf16(f[0], f[1]); w0.y = pk_bf16(f[2], f[3]); w0.z = pk_bf16(f[4], f[5]); w0.w = pk_bf16(f[6], f[7]);
      w1.x = pk_bf16(f[8], f[9]); w1.y = pk_bf16(f[10], f[11]); w1.z = pk_bf16(f[12], f[13]); w1.w = pk_bf16(f[14], f[15]);
      u32x4* dp = (u32x4*)(dst + (size_t)(n0 + r2) * K + k0 + kc * 16); dp[0] = w0; dp[1] = w1; }
    __syncthreads();
}
__device__ __forceinline__ void p0_init(LAS unsigned char* lds, int G, int bid, int tid) {
    const int wave = tid >> 6, lane = tid & 63;
    float* h32 = (float*)(gws() + WS_H32); bf16_t* hb = (bf16_t*)(gws() + WS_HB); float* ss = (float*)(gws() + WS_SS);
    for (int row = bid * 8 + wave; row < MPAD; row += G * 8) {
        const float* src = nullptr;
        if (row < MPROMPT) { const int b = row / LP, pos = row - b * LP; src = pos < 16 ? gin(5) + (size_t)pos * D : gin(0) + ((size_t)b * SEQ + pos - 16) * D; }
        else if (row < M) src = gin(1) + (size_t)(row - MPROMPT) * D;
        float s = 0.f;
#pragma unroll
        for (int i = 0; i < 4; ++i) {
            const int c = (i * 64 + lane) * 4;
            f32x4 v = (f32x4){0.f, 0.f, 0.f, 0.f};
            if (src) v = *(const f32x4*)(src + c);
            *(f32x4*)(h32 + (size_t)row * D + c) = v;
            u32x2 w; w.x = pk_bf16(v[0], v[1]); w.y = pk_bf16(v[2], v[3]);
            *(u32x2*)(hb + (size_t)row * D + c) = w;
            s += v[0] * v[0] + v[1] * v[1] + v[2] * v[2] + v[3] * v[3];
        }
#pragma unroll
        for (int o = 32; o > 0; o >>= 1) s += __shfl_xor(s, o);
        if (lane < 16) ss[(size_t)row * 16 + lane] = (lane == 0) ? s : 0.f;
    }
    const int gt = bid * NTHREADS + tid;
    if (gt < 512) {
        float v[4], mx = -1e30f;
        for (int l = 0; l < 4; ++l) { v[l] = gin(6)[l * 512 + gt]; mx = fmaxf(mx, v[l]); }
        float sum = 0.f; for (int l = 0; l < 4; ++l) { v[l] = expf(v[l] - mx); sum += v[l]; }
        float* lb = (float*)(gws() + WS_LB); float c = 0.f;
        for (int l = 0; l < 4; ++l) { lb[l * 512 + gt] = c; if (l < 3) c += v[l + 1] / sum; }
    }
    {
        const int i = gt - 512;
        if (i >= 0 && i < 4 * 32 * 64) {
            const int pidx = i & 63, lg = i >> 6;
            const float dt = expf(gin(16)[lg]);
            const float lr = fminf(gin(14)[i], -1e-4f), li = gin(15)[i];
            const float mag = expf(lr * dt), ar = mag * cosf(li * dt), ai = mag * sinf(li * dt);
            const float den = lr * lr + li * li;
            const float cr = ((ar - 1.f) * lr + ai * li) / den, ci = (ai * lr - (ar - 1.f) * li) / den;
            ((f32x2*)(gws() + WS_ABAR))[i] = (f32x2){ar, ai};
            bf16_t* bbT = (bf16_t*)(gws() + WS_BBT); bf16_t* cT = (bf16_t*)(gws() + WS_CT);
            for (int h = 0; h < 16; ++h) {
                const float br = gin(17)[(size_t)i * 16 + h], bi = gin(18)[(size_t)i * 16 + h];
                bbT[((size_t)lg * 128 + 2 * pidx) * 16 + h] = to_bf16(cr * br - ci * bi);
                bbT[((size_t)lg * 128 + 2 * pidx + 1) * 16 + h] = to_bf16(cr * bi + ci * br);
                cT[((size_t)lg * 16 + h) * 128 + 2 * pidx] = to_bf16(gin(19)[((size_t)lg * 16 + h) * 64 + pidx]);
                cT[((size_t)lg * 16 + h) * 128 + 2 * pidx + 1] = to_bf16(-gin(20)[((size_t)lg * 16 + h) * 64 + pidx]);
            }
        }
    }
    for (int t = bid; t < 4 * 2592; t += G) convert_tile(t, (LAS float*)lds, tid);
}

__device__ __forceinline__ void hgrn_core(const bf16x8 (&q)[4], const bf16x8 (&k)[4], const bf16x4 (&kT)[8], const bf16x4 v, const f32x4 (&av)[8],
                                          f32x4 (&S)[8], float* orow, f32x4& oout, bool sample, int fqm, int fr, int fq) {
    f32x4 sc = (f32x4){0.f, 0.f, 0.f, 0.f};
#pragma unroll
    for (int kk = 0; kk < 4; ++kk) sc = mfma32(k[kk], q[kk], sc);
    MFMA_FENCE();
#pragma unroll
    for (int i = 0; i < 4; ++i) { bool keep = (4 * fq + i) <= fr; if (sample) keep = keep && (fq == (fr >> 2)); sc[i] = keep ? sc[i] : 0.f; }
    u32x2 pw; pw.x = pk_bf16(sc[0], sc[1]); pw.y = pk_bf16(sc[2], sc[3]);
    f32x4 o = mfma16(__builtin_bit_cast(bf16x4, pw), v, (f32x4){0.f, 0.f, 0.f, 0.f});
#pragma unroll
    for (int kk = 0; kk < 4; ++kk) {
        u32x4 sb; sb.x = pk_bf16(S[2 * kk][0], S[2 * kk][1]); sb.y = pk_bf16(S[2 * kk][2], S[2 * kk][3]);
        sb.z = pk_bf16(S[2 * kk + 1][0], S[2 * kk + 1][1]); sb.w = pk_bf16(S[2 * kk + 1][2], S[2 * kk + 1][3]);
        o = mfma32(q[kk], __builtin_bit_cast(bf16x8, sb), o);
    }
    MFMA_FENCE();
    oout = o;
    if (orow != nullptr && (!sample || fq == fqm)) {
#pragma unroll
        for (int i = 0; i < 4; ++i) orow[(size_t)(4 * fq + i) * 512] = o[i];
    }
#pragma unroll
    for (int blk = 0; blk < 8; ++blk) {
        bf16x4 kt = kT[blk];
        if (sample && fq != fqm) kt = (bf16x4){0, 0, 0, 0};
        S[blk] = mfma16(kt, v, S[blk]);
    }
    MFMA_FENCE();
#pragma unroll
    for (int blk = 0; blk < 8; ++blk) S[blk] *= av[blk];
}
__device__ __forceinline__ void hgrn_sample_item(int l, int b, int h, int wave, int lane) {
    const int fr = lane & 15, fq = lane >> 4, cb = 128 * h, v0 = cb + 16 * wave;
    const bf16_t* qt = (const bf16_t*)(gws() + WS_QT); const bf16_t* kt = (const bf16_t*)(gws() + WS_KT);
    const bf16_t* ktT = (const bf16_t*)(gws() + WS_KTT); const bf16_t* vT = (const bf16_t*)(gws() + WS_VT);
    float* oraw = (float*)(gws() + WS_ORAW);
    const int R0 = MPROMPT + 4 * b, r0 = R0 & ~15, fqm = b & 3;
    f32x4 S[8];
    const float* s0 = gin(2) + (((size_t)l * 128 + b) * 4 + h) * 16384;
#pragma unroll
    for (int blk = 0; blk < 8; ++blk)
#pragma unroll
        for (int i = 0; i < 4; ++i) S[blk][i] = s0[(size_t)(16 * blk + 4 * fq + i) * 128 + 16 * wave + fr];
    bf16x8 q[4], k[4]; bf16x4 kT[8], v; f32x4 av[8];
    const size_t ro = (size_t)(r0 + fr) * 512 + cb + 4 * fq;
#pragma unroll
    for (int kk = 0; kk < 4; ++kk) {
        const u32x2 a0 = *(const u32x2*)(qt + ro + 32 * kk), a1 = *(const u32x2*)(qt + ro + 32 * kk + 16);
        const u32x2 b0 = *(const u32x2*)(kt + ro + 32 * kk), b1 = *(const u32x2*)(kt + ro + 32 * kk + 16);
        q[kk] = __builtin_bit_cast(bf16x8, ((u32x4){a0.x, a0.y, a1.x, a1.y})); k[kk] = __builtin_bit_cast(bf16x8, ((u32x4){b0.x, b0.y, b1.x, b1.y}));
    }
    const size_t to = (size_t)(r0 >> 4) * 512 * 16 + 4 * fq;
    const float* ap = (const float*)(gws() + WS_ADECS) + (size_t)b * 512 + cb + 4 * fq;
#pragma unroll
    for (int blk = 0; blk < 8; ++blk) { kT[blk] = *(const bf16x4*)(ktT + to + (size_t)(cb + 16 * blk + fr) * 16); av[blk] = *(const f32x4*)(ap + 16 * blk); }
    v = *(const bf16x4*)(vT + to + (size_t)(v0 + fr) * 16);
    f32x4 odummy;
    hgrn_core(q, k, kT, v, av, S, oraw + (size_t)r0 * 512 + v0 + fr, odummy, true, fqm, fr, fq);
    float* so = gout() + O_HGS + (((size_t)l * 128 + b) * 4 + h) * 16384;
#pragma unroll
    for (int blk = 0; blk < 8; ++blk)
#pragma unroll
        for (int i = 0; i < 4; ++i) so[(size_t)(16 * blk + 4 * fq + i) * 128 + 16 * wave + fr] = S[blk][i];
}
constexpr int HST = 16896, HNS = 7;
__device__ __forceinline__ void hgrn_issue(LAS unsigned char* lds, int ci, int row0, int cb, int wave, int lane) {
    const int cc = ci < 129 ? ci : 128, r0 = row0 + 16 * cc, chunk = r0 >> 4;
    LAS unsigned char* st = lds + (ci % HNS) * HST;
    const unsigned char* ws = gws();
    const int w4 = wave - 4, t = w4 * 64 + lane, row = t >> 4, c = (t & 15) ^ row;
    const size_t rowoff = ((size_t)(r0 + row) * 512 + cb + c * 8) * 2, toff = ((size_t)chunk * 512 + cb) * 32 + (size_t)t * 16;
    __builtin_amdgcn_global_load_lds((const unsigned*)(ws + WS_QT + rowoff), (LAS unsigned*)(st + w4 * 1024), 16, 0, 0);
    __builtin_amdgcn_global_load_lds((const unsigned*)(ws + WS_KT + rowoff), (LAS unsigned*)(st + 4096 + w4 * 1024), 16, 0, 0);
    __builtin_amdgcn_global_load_lds((const unsigned*)(ws + WS_KTT + toff), (LAS unsigned*)(st + 8192 + w4 * 1024), 16, 0, 0);
    __builtin_amdgcn_global_load_lds((const unsigned*)(ws + WS_VT + toff), (LAS unsigned*)(st + 12288 + w4 * 1024), 16, 0, 0);
    if (wave == 4 && lane < 32)
        __builtin_amdgcn_global_load_lds((const unsigned*)(ws + WS_ADEC + ((size_t)chunk * 512 + cb) * 4 + lane * 16), (LAS unsigned*)(st + 16384), 16, 0, 0);
}
__device__ __forceinline__ void hgrn_scores(LAS const unsigned char* st, LAS unsigned char* pb, int lane) {
    const int fr = lane & 15, fq = lane >> 4;
    f32x4 sc = (f32x4){0.f, 0.f, 0.f, 0.f};
#pragma unroll
    for (int kk = 0; kk < 4; ++kk) {
        const int e0 = 32 * kk + 4 * fq, e1 = e0 + 16;
        const int o0 = fr * 256 + (((e0 >> 3) ^ fr) << 4) + (e0 & 7) * 2, o1 = fr * 256 + (((e1 >> 3) ^ fr) << 4) + (e1 & 7) * 2;
        const u32x2 a0 = *(LAS const u32x2*)(st + o0), a1 = *(LAS const u32x2*)(st + o1);
        const u32x2 b0 = *(LAS const u32x2*)(st + 4096 + o0), b1 = *(LAS const u32x2*)(st + 4096 + o1);
        sc = mfma32(__builtin_bit_cast(bf16x8, ((u32x4){b0.x, b0.y, b1.x, b1.y})), __builtin_bit_cast(bf16x8, ((u32x4){a0.x, a0.y, a1.x, a1.y})), sc);
    }
    MFMA_FENCE();
#pragma unroll
    for (int i = 0; i < 4; ++i) sc[i] = ((4 * fq + i) <= fr) ? sc[i] : 0.f;
    u32x2 pw; pw.x = pk_bf16(sc[0], sc[1]); pw.y = pk_bf16(sc[2], sc[3]);
    *(LAS u32x2*)(pb + lane * 8) = pw;
}
__device__ __forceinline__ void hgrn_core_p(const bf16x8 (&q)[4], const bf16x4 P, const bf16x4 (&kT)[8], const bf16x4 v, const f32x4 (&av)[8], f32x4 (&S)[8], f32x4& oout) {
    f32x4 o = mfma16(P, v, (f32x4){0.f, 0.f, 0.f, 0.f});
#pragma unroll
    for (int kk = 0; kk < 4; ++kk) {
        u32x4 sb; sb.x = pk_bf16(S[2 * kk][0], S[2 * kk][1]); sb.y = pk_bf16(S[2 * kk][2], S[2 * kk][3]);
        sb.z = pk_bf16(S[2 * kk + 1][0], S[2 * kk + 1][1]); sb.w = pk_bf16(S[2 * kk + 1][2], S[2 * kk + 1][3]);
        o = mfma32(q[kk], __builtin_bit_cast(bf16x8, sb), o);
    }
#pragma unroll
    for (int blk = 0; blk < 8; ++blk) S[blk] = mfma16(kT[blk], v, S[blk]);
    MFMA_FENCE();
    oout = o;
#pragma unroll
    for (int blk = 0; blk < 8; ++blk) S[blk] *= av[blk];
}
__device__ __forceinline__ void hgrn_prompt_item(int l, int b, int h, int half, LAS unsigned char* lds, int tid, int wave, int lane) {
    const int fr = lane & 15, fq = lane >> 4, cb_ = 128 * h, vloc = 64 * half + 16 * (wave & 3), v0 = cb_ + vloc, row0 = b * LP;
    const bool comp = wave < 4;
    LAS unsigned char* pbuf = lds + HNS * HST;
    float* oraw = (float*)(gws() + WS_ORAW);
    f32x4 S[8];
#pragma unroll
    for (int blk = 0; blk < 8; ++blk) S[blk] = (f32x4){0.f, 0.f, 0.f, 0.f};
    if (!comp) {
        for (int ci = 0; ci < HNS - 1; ++ci) hgrn_issue(lds, ci, row0, cb_, wave, lane);
        if (wave == 4) asm volatile("s_waitcnt vmcnt(25)" ::: "memory"); else asm volatile("s_waitcnt vmcnt(20)" ::: "memory");
    }
    __builtin_amdgcn_s_barrier();
    asm volatile("" ::: "memory");
    if (wave == 5) { hgrn_scores(lds, pbuf, lane); LGKM0(); }
    f32x4 ob[4];
    for (int cb = 0; cb < 129; cb += 4) {
#pragma unroll
        for (int j = 0; j < 4; ++j) {
            const int ci = cb + j;
            if (ci < 129) {
                if (wave == 4) asm volatile("s_waitcnt vmcnt(20)" ::: "memory"); else if (wave > 4) asm volatile("s_waitcnt vmcnt(16)" ::: "memory");
                __builtin_amdgcn_s_barrier();
                asm volatile("" ::: "memory");
                if (comp) {
                    if (j == 0 && cb > 0) {
#pragma unroll
                        for (int jj = 0; jj < 4; ++jj)
#pragma unroll
                            for (int i = 0; i < 4; ++i) oraw[(size_t)(row0 + 16 * (cb - 4 + jj) + 4 * fq + i) * 512 + v0 + fr] = ob[jj][i];
                    }
                    LAS const unsigned char* st = lds + (ci % HNS) * HST;
                    bf16x8 q[4]; bf16x4 kT[8], v; f32x4 av[8];
#pragma unroll
                    for (int kk = 0; kk < 4; ++kk) {
                        const int e0 = 32 * kk + 4 * fq, e1 = e0 + 16;
                        const int o0 = fr * 256 + (((e0 >> 3) ^ fr) << 4) + (e0 & 7) * 2, o1 = fr * 256 + (((e1 >> 3) ^ fr) << 4) + (e1 & 7) * 2;
                        const u32x2 a0 = *(LAS const u32x2*)(st + o0), a1 = *(LAS const u32x2*)(st + o1);
                        q[kk] = __builtin_bit_cast(bf16x8, ((u32x4){a0.x, a0.y, a1.x, a1.y}));
                    }
#pragma unroll
                    for (int blk = 0; blk < 8; ++blk) {
                        kT[blk] = *(LAS const bf16x4*)(st + 8192 + (16 * blk + fr) * 32 + 8 * fq);
                        av[blk] = *(LAS const f32x4*)(st + 16384 + (16 * blk + 4 * fq) * 4);
                    }
                    v = *(LAS const bf16x4*)(st + 12288 + (vloc + fr) * 32 + 8 * fq);
                    const bf16x4 P = *(LAS const bf16x4*)(pbuf + (ci & 1) * 512 + lane * 8);
                    hgrn_core_p(q, P, kT, v, av, S, ob[j]);
                } else {
                    hgrn_issue(lds, ci + HNS - 1, row0, cb_, wave, lane);
                    if (wave == 5 && ci + 1 < 129) { hgrn_scores(lds + ((ci + 1) % HNS) * HST, pbuf + ((ci + 1) & 1) * 512, lane); LGKM0(); }
                }
            }
        }
    }
    if (comp) {
#pragma unroll
        for (int i = 0; i < 4; ++i) oraw[(size_t)(row0 + 16 * 128 + 4 * fq + i) * 512 + v0 + fr] = ob[0][i];
    }
    asm volatile("s_waitcnt vmcnt(0)" ::: "memory");
    __syncthreads();
    if (comp) {
        float* so = gout() + O_HGP + (((size_t)l * 8 + b) * 4 + h) * 16384;
#pragma unroll
        for (int blk = 0; blk < 8; ++blk)
#pragma unroll
            for (int i = 0; i < 4; ++i) so[(size_t)(16 * blk + 4 * fq + i) * 128 + vloc + fr] = S[blk][i];
    }
}

struct S5C { bf16x4 Bb[8]; bf16x8 Cf[4]; float ar, ai, dsk; };
__device__ __forceinline__ void s5_load_const(S5C& c, int l, int g, int lane) {
    const int fr = lane & 15, fq = lane >> 4, lg = l * 32 + g;
    const bf16_t* bbT = (const bf16_t*)(gws() + WS_BBT); const bf16_t* cT = (const bf16_t*)(gws() + WS_CT);
#pragma unroll
    for (int blk = 0; blk < 8; ++blk) c.Bb[blk] = *(const bf16x4*)(bbT + ((size_t)lg * 128 + 16 * blk + fr) * 16 + 4 * fq);
#pragma unroll
    for (int kk = 0; kk < 4; ++kk) c.Cf[kk] = *(const bf16x8*)(cT + ((size_t)lg * 16 + fr) * 128 + 32 * kk + 8 * fq);
    const f32x2 a = ((const f32x2*)(gws() + WS_ABAR))[lg * 64 + lane];
    c.ar = a.x; c.ai = a.y; c.dsk = gin(21)[lg * 16 + fr];
}
__device__ __forceinline__ bf16x4 s5_ua(const bf16_t* ub, int r0, int g, int fr, int fq) { return *(const bf16x4*)(ub + (size_t)(r0 + fr) * 512 + 16 * g + 4 * fq); }
__device__ __forceinline__ void s5_bu_v(const S5C& c, const bf16x4 ua, LAS float* bu, int fr, int fq);
__device__ __forceinline__ void s5_bu(const S5C& c, const bf16_t* ub, int r0, int g, LAS float* bu, int fr, int fq) { s5_bu_v(c, s5_ua(ub, r0, g, fr, fq), bu, fr, fq); }
__device__ __forceinline__ void s5_bu_v(const S5C& c, const bf16x4 ua, LAS float* bu, int fr, int fq) {
    f32x4 d[8];
#pragma unroll
    for (int blk = 0; blk < 8; ++blk) d[blk] = mfma16(ua, c.Bb[blk], (f32x4){0.f, 0.f, 0.f, 0.f});
    MFMA_FENCE();
#pragma unroll
    for (int blk = 0; blk < 8; ++blk)
#pragma unroll
        for (int i = 0; i < 4; ++i) bu[(4 * fq + i) * 132 + 16 * blk + fr] = d[blk][i];
}
__device__ __forceinline__ void s5_uu(unsigned (&uu)[4], const bf16_t* ub, int r0, int g, int fr, int fq) {
#pragma unroll
    for (int i = 0; i < 4; ++i) uu[i] = ub[(size_t)(r0 + 4 * fq + i) * 512 + 16 * g + fr];
}
__device__ __forceinline__ void s5_y(const S5C& c, const unsigned (&uu)[4], bf16_t* yg, int r0, int g, LAS const bf16_t* xs, int fr, int fq) {
    f32x4 y = (f32x4){0.f, 0.f, 0.f, 0.f};
#pragma unroll
    for (int kk = 0; kk < 4; ++kk) { const bf16x8 a = *(LAS const bf16x8*)(xs + fr * 136 + 32 * kk + 8 * fq); y = mfma32(a, c.Cf[kk], y); }
    MFMA_FENCE();
#pragma unroll
    for (int i = 0; i < 4; ++i) {
        const size_t o = (size_t)(r0 + 4 * fq + i) * 512 + 16 * g + fr;
        const float uf = __uint_as_float(uu[i] << 16);
        yg[o] = to_bf16(gelu_tanh(y[i] + c.dsk * uf));
    }
}
__device__ __forceinline__ void s5_prompt_item(int l, int b, int g, LAS unsigned char* lds, int wave, int lane) {
    const int fr = lane & 15, fq = lane >> 4;
    LAS float* bu = (LAS float*)(lds + wave * 12800); LAS bf16_t* xs = (LAS bf16_t*)(lds + wave * 12800 + 8448);
    LAS float* carr = (LAS float*)(lds + 8 * 12800);
    const bf16_t* ub = (const bf16_t*)(gws() + WS_UB); bf16_t* yg = (bf16_t*)(gws() + WS_YG);
    S5C c; s5_load_const(c, l, g, lane);
    const int c0 = 16 * wave, c1 = (wave == 7) ? 129 : 16 * wave + 16, row0 = b * LP;
#ifdef DIAG_NO_S5
    for (int ci = c0; ci < c1; ++ci) for (int i = 0; i < 4; ++i) yg[(size_t)(row0 + 16 * ci + 4 * fq + i) * 512 + 16 * g + fr] = 0;
    if (wave == 7) { const size_t o = (((size_t)l * 8 + b) * 32 + g) * 64 + lane; gout()[O_S5RP + o] = 0.f; gout()[O_S5IP + o] = 0.f; }
    return;
#endif
    float xr = 0.f, xi = 0.f;
    if (wave < 7) {
        bf16x4 ua_n = s5_ua(ub, row0 + 16 * c0, g, fr, fq);
        for (int ci = c0; ci < c1; ++ci) {
            const bf16x4 ua = ua_n;
            ua_n = s5_ua(ub, row0 + 16 * (ci + 1 < c1 ? ci + 1 : ci), g, fr, fq);
            s5_bu_v(c, ua, bu, fr, fq);
            LGKM0();
            f32x2 bv[16];
#pragma unroll
            for (int t = 0; t < 16; ++t) bv[t] = *(LAS const f32x2*)(bu + t * 132 + 2 * lane);
#pragma unroll
            for (int t = 0; t < 16; ++t) { const float nr = c.ar * xr - c.ai * xi + bv[t].x, ni = c.ar * xi + c.ai * xr + bv[t].y; xr = nr; xi = ni; }
            LGKM0();
        }
    }
    carr[(wave * 64 + lane) * 2] = xr; carr[(wave * 64 + lane) * 2 + 1] = xi;
    __syncthreads();
    float pr = c.ar, pi = c.ai;
#pragma unroll
    for (int s = 0; s < 8; ++s) { const float nr = pr * pr - pi * pi, ni = 2.f * pr * pi; pr = nr; pi = ni; }
    xr = 0.f; xi = 0.f;
    for (int w = 0; w < wave; ++w) {
        const float lr = carr[(w * 64 + lane) * 2], li = carr[(w * 64 + lane) * 2 + 1];
        const float nr = pr * xr - pi * xi + lr, ni = pr * xi + pi * xr + li; xr = nr; xi = ni;
    }
    bf16x4 ua_n = s5_ua(ub, row0 + 16 * c0, g, fr, fq); unsigned uu_n[4]; s5_uu(uu_n, ub, row0 + 16 * c0, g, fr, fq);
    for (int ci = c0; ci < c1; ++ci) {
        const int r0 = row0 + 16 * ci, rn = row0 + 16 * (ci + 1 < c1 ? ci + 1 : ci);
        const bf16x4 ua = ua_n; unsigned uu[4];
#pragma unroll
        for (int i = 0; i < 4; ++i) uu[i] = uu_n[i];
        ua_n = s5_ua(ub, rn, g, fr, fq); s5_uu(uu_n, ub, rn, g, fr, fq);
        s5_bu_v(c, ua, bu, fr, fq);
        LGKM0();
        f32x2 bv[16]; unsigned xp[16];
#pragma unroll
        for (int t = 0; t < 16; ++t) bv[t] = *(LAS const f32x2*)(bu + t * 132 + 2 * lane);
#pragma unroll
        for (int t = 0; t < 16; ++t) { const float nr = c.ar * xr - c.ai * xi + bv[t].x, ni = c.ar * xi + c.ai * xr + bv[t].y; xr = nr; xi = ni; xp[t] = pk_bf16(xr, xi); }
#pragma unroll
        for (int t = 0; t < 16; ++t) *(LAS unsigned*)(xs + t * 136 + 2 * lane) = xp[t];
        LGKM0();
        s5_y(c, uu, yg, r0, g, xs, fr, fq);
        LGKM0();
    }
    if (wave == 7) {
        const size_t o = (((size_t)l * 8 + b) * 32 + g) * 64 + lane;
        gout()[O_S5RP + o] = xr; gout()[O_S5IP + o] = xi;
    }
    __syncthreads();
}
__device__ __forceinline__ void s5_sample_wave(int l, int bblk, int g, LAS unsigned char* lds, int wave, int lane) {
    const int fr = lane & 15, fq = lane >> 4;
    LAS float* bu = (LAS float*)(lds + wave * 12800); LAS bf16_t* xs = (LAS bf16_t*)(lds + wave * 12800 + 8448);
    const bf16_t* ub = (const bf16_t*)(gws() + WS_UB); bf16_t* yg = (bf16_t*)(gws() + WS_YG);
    S5C c; s5_load_const(c, l, g, lane);
    const int r0 = MPROMPT + 16 * bblk;
#ifdef DIAG_NO_S5
    for (int i = 0; i < 4; ++i) yg[(size_t)(r0 + 4 * fq + i) * 512 + 16 * g + fr] = 0;
    for (int s = 0; s < 4; ++s) { const size_t o = (((size_t)l * 128 + 4 * bblk + s) * 32 + g) * 64 + lane; gout()[O_S5RS + o] = 0.f; gout()[O_S5IS + o] = 0.f; }
    return;
#endif
    unsigned uu[4]; s5_uu(uu, ub, r0, g, fr, fq);
    s5_bu(c, ub, r0, g, bu, fr, fq);
    LGKM0();
#pragma unroll
    for (int s = 0; s < 4; ++s) {
        const int b = 4 * bblk + s;
        const size_t o = (((size_t)l * 128 + b) * 32 + g) * 64 + lane;
        float xr = gin(3)[o], xi = gin(4)[o];
#pragma unroll
        for (int tt = 0; tt < 4; ++tt) {
            const int t = 4 * s + tt;
            const f32x2 bv = *(LAS const f32x2*)(bu + t * 132 + 2 * lane);
            const float nr = c.ar * xr - c.ai * xi + bv.x, ni = c.ar * xi + c.ai * xr + bv.y; xr = nr; xi = ni;
            *(LAS unsigned*)(xs + t * 136 + 2 * lane) = pk_bf16(xr, xi);
        }
        gout()[O_S5RS + o] = xr; gout()[O_S5IS + o] = xi;
    }
    LGKM0();
    s5_y(c, uu, yg, r0, g, xs, fr, fq);
    LGKM0();
}

#define BW_XCNT(x) (32 * (x))
#define BW_XSUB(x) (32 * (16 + (x)))
#define BW_XGEN(x) (32 * (32 + (x)))
#define BW_TOP (32 * 48)
#define BW_TOPGEN (32 * 49)
__device__ __forceinline__ unsigned bw_ld(unsigned* p) { return __hip_atomic_load(p, __ATOMIC_RELAXED, __HIP_MEMORY_SCOPE_AGENT); }
__device__ __forceinline__ unsigned bw_add(unsigned* p, unsigned v) { return __hip_atomic_fetch_add(p, v, __ATOMIC_RELAXED, __HIP_MEMORY_SCOPE_AGENT); }
__device__ __forceinline__ unsigned xcc_id() { return (unsigned)__builtin_amdgcn_s_getreg((3 << 11) | 20) & 0xFu; }
#define BW_SPIN(cond) do { unsigned _sp = 0; while (cond) { __builtin_amdgcn_s_sleep(1); if (++_sp > (1u << 22)) break; } } while (0)
__device__ __forceinline__ void fast_grid_barrier(unsigned* bar, unsigned k, unsigned x, unsigned nloc, unsigned nx, int tidnow) {
    asm volatile("s_waitcnt vmcnt(0) lgkmcnt(0)" ::: "memory");
    __syncthreads();
    if (tidnow == 0) {
        const unsigned old = bw_add(&bar[BW_XSUB(x)], 1u);
        if (old + 1u == k * nloc) {
            __builtin_amdgcn_fence(__ATOMIC_RELEASE, "agent");
            asm volatile("s_waitcnt vmcnt(0)" ::: "memory");
            const unsigned og = bw_add(&bar[BW_TOP], 1u);
            if (og + 1u == k * nx) bw_add(&bar[BW_TOPGEN], 1u);
            else BW_SPIN(bw_ld(&bar[BW_TOPGEN]) < k);
            __builtin_amdgcn_fence(__ATOMIC_ACQUIRE, "agent");
            bw_add(&bar[BW_XGEN(x)], 1u);
            asm volatile("s_waitcnt vmcnt(0)" ::: "memory");
        } else {
            BW_SPIN(bw_ld(&bar[BW_XGEN(x)]) < k);
            __builtin_amdgcn_fence(__ATOMIC_ACQUIRE, "agent");
            asm volatile("s_waitcnt vmcnt(0)" ::: "memory");
        }
    }
    __syncthreads();
}
__device__ __forceinline__ void finish_remainder(unsigned char* ws, int ssni, int ss5i, int bid, int G, int wave, int lane) {
    pg8::Order S; S.init(MPAD / 256, D / 256, G, bid, 1, 512);
    float* h32 = (float*)(ws + WS_H32); bf16_t* hbw = (bf16_t*)(ws + WS_HB);
    float* ssn = (float*)(ws + WS_SS) + (size_t)ssni * MPAD * 16;
    const int nrem = S.nwg - G;
    for (int task = bid * 8 + wave; task < nrem * 256; task += G * 8) {
        int pm, pn; S.tile_of(G + (task >> 8), pm, pn);
        const int row = pm * 256 + (task & 255), c = pn * 256 + lane * 4;
        f32x4 v = *(const f32x4*)(h32 + (size_t)row * D + c);
        const float* pb = (const float*)(ws + WS_PART) + (size_t)(task >> 8) * 4 * 65536 + (size_t)(task & 255) * 256 + lane * 4;
        const f32x4 p0 = *(const f32x4*)(pb), p1 = *(const f32x4*)(pb + 65536), p2 = *(const f32x4*)(pb + 2 * 65536), p3 = *(const f32x4*)(pb + 3 * 65536);
        float sc = 1.f;
        if (ss5i >= 0) sc = rsqrtf(row_ss8((const float*)(ws + WS_SS) + (size_t)ss5i * MPAD * 16, row) * (1.f / 512.f) + EPS);
        v += (p0 + p1) + (p2 + p3) * sc;
        *(f32x4*)(h32 + (size_t)row * D + c) = v;
        u32x2 w; w.x = pk_bf16(v[0], v[1]); w.y = pk_bf16(v[2], v[3]);
        *(u32x2*)(hbw + (size_t)row * D + c) = w;
        float sq = v[0] * v[0] + v[1] * v[1] + v[2] * v[2] + v[3] * v[3];
#pragma unroll
        for (int o = 32; o > 0; o >>= 1) sq += __shfl_xor(sq, o);
        if (lane < 4) ssn[(size_t)row * 16 + pn * 4 + lane] = (lane == 0) ? sq : 0.f;
    }
}
#define GRID_SYNC() do { asm volatile("s_waitcnt vmcnt(0) lgkmcnt(0)" ::: "memory"); grid.sync(); if (wave0 == 0) asm volatile("buffer_inv sc1\n\ts_waitcnt vmcnt(0)" ::: "memory"); __syncthreads(); } while (0)
__global__ void __launch_bounds__(NTHREADS, 2) fwd_megakernel(Params p) {
    extern __shared__ __attribute__((aligned(16))) unsigned char lds_raw[];
    LAS unsigned char* lds = (LAS unsigned char*)lds_raw;
    cg::grid_group grid = cg::this_grid();
    const int bid0 = blockIdx.x, G0 = gridDim.x;
    const int wave0 = __builtin_amdgcn_readfirstlane(threadIdx.x >> 6);
#define TID_NOW() ({ unsigned _m = ~0u; asm volatile("" : "+s"(_m)); wave0 * 64 + (int)__builtin_amdgcn_mbcnt_hi(_m, __builtin_amdgcn_mbcnt_lo(_m, 0u)); })

    const unsigned myx = xcc_id();
    if (threadIdx.x == 0) bw_add((unsigned*)(gws() + WS_BAR) + BW_XCNT(myx), 1u);
    p0_init(lds, G0, bid0, TID_NOW());
    GRID_SYNC();
    unsigned nloc = 0u, nx = 0u;
    { unsigned* bar = (unsigned*)(gws() + WS_BAR);
      for (unsigned j = 0; j < 16; ++j) { const unsigned c = bw_ld(&bar[BW_XCNT(j)]); nx += (c > 0u) ? 1u : 0u; nloc = (j == myx) ? c : nloc; }
      nloc = __builtin_amdgcn_readfirstlane(nloc); nx = __builtin_amdgcn_readfirstlane(nx); }

    unsigned kb = 0u;
    constexpr int NSLOT = (DUP_SLOT >= 0) ? 9 : 8;
    for (int step = 0; step < DEPTH * NSLOT; ++step) {
        const int l = step / NSLOT, s9 = step - l * NSLOT, s = (DUP_SLOT >= 0 && s9 > DUP_SLOT) ? s9 - 1 : s9;
        int bid = bid0, G = G0; asm volatile("" : "+s"(bid), "+s"(G));
        unsigned char* ws = launder(gws());
        const bf16_t* hb = (const bf16_t*)(ws + WS_HB); const bf16_t* act = (const bf16_t*)(ws + WS_ACT);
        int tid = TID_NOW(); asm volatile("" : "+v"(tid));
        const int wave = wave0, lane = tid & 63;
        unsigned char* wl = ws + WS_W + (size_t)l * WL_SZ;
        int fin_ssn = -1, fin_ss5 = -1;
        if (EN(0) && (s == 0 || s == 6)) {
            pg8::Gemm g{hb, (const bf16_t*)(wl + (s == 0 ? WL_A1 : WL_A2)), D, D, D};
            pg8::Order S; S.init(MPAD / 256, FFN2 / 256, G, bid, 1, D, KREP_UP);
            EpiSwiglu E{ws, 3 * l + (s == 0 ? 0 : 2)};
            pg8::gemm_phase(lds, g, S, E, tid);
        } else if (EN(1) && (s == 1 || s == 7)) {
            pg8::Gemm g{act, (const bf16_t*)(wl + (s == 1 ? WL_D1 : WL_D2)), FFN, FFN, FFN};
            pg8::Order S; S.init(MPAD / 256, D / 256, G, bid, 1, FFN, 1, (G == 256) ? DOWN_SPLIT : 0);
            EpiRes E{ws, 3 * l + (s == 1 ? 1 : 3), -1, 0.5f};
            pg8::gemm_phase(lds, g, S, E, tid);
            if (S.nsplit > 0) { fin_ssn = 3 * l + (s == 1 ? 1 : 3); fin_ss5 = -1; }
        } else if (EN(2) && s == 2) {
            pg8::Gemm g{hb, (const bf16_t*)(wl + WL_IN), D, D, D};
            pg8::Order S; S.init(MPAD / 256, INC / 256, G, bid, 1, D);
            EpiWin E{ws, l};
            pg8::gemm_phase(lds, g, S, E, tid);
        } else if (EN(3) && s == 3) {
            {
                if (bid < 64) hgrn_prompt_item(l, bid >> 3, (bid >> 1) & 3, bid & 1, lds, tid, wave, lane);
                else { for (int it = bid - 64; it < 256; it += G - 64) s5_prompt_item(l, it >> 5, it & 31, lds, wave, lane); }
                if (bid >= 128) {
                    for (int it = bid - 128; it < 640; it += G - 128) {
                        if (it < 512) hgrn_sample_item(l, it >> 2, it & 3, wave, lane);
                        else { const int wi = (it - 512) * 8 + wave; s5_sample_wave(l, wi >> 5, wi & 31, lds, wave, lane); }
                    }
                }
            }
        } else if (EN(4) && s == 4) {
            {
                pg8::Gemm g{(const bf16_t*)(ws + WS_YG), (const bf16_t*)(wl + WL_GLU), 512, 512, 512};
                pg8::Order S; S.init(MPAD / 256, 2, G, bid, 1, 512);
                EpiGlu E{ws, l};
                pg8::gemm_phase(lds, g, S, E, tid);
            }
            const float* oraw = (const float*)(ws + WS_ORAW); const bf16_t* gs = (const bf16_t*)(ws + WS_GS); bf16_t* mixin = (bf16_t*)(ws + WS_MIXIN);
            for (int row = bid * 8 + wave; row < M; row += G * 8) {
                const int c = lane * 8;
                const f32x4 a = *(const f32x4*)(oraw + (size_t)row * 512 + c), b = *(const f32x4*)(oraw + (size_t)row * 512 + c + 4);
                float sq = a[0] * a[0] + a[1] * a[1] + a[2] * a[2] + a[3] * a[3] + b[0] * b[0] + b[1] * b[1] + b[2] * b[2] + b[3] * b[3];
                sq += __shfl_xor(sq, 1); sq += __shfl_xor(sq, 2); sq += __shfl_xor(sq, 4); sq += __shfl_xor(sq, 8);
                const float r = rsqrtf(sq * (1.f / 128.f) + EPS);
                const u32x4 gw = *(const u32x4*)(gs + (size_t)row * 512 + c);
                u32x4 w;
                w.x = pk_bf16(a[0] * r * bf16_lo(gw.x), a[1] * r * bf16_hi(gw.x)); w.y = pk_bf16(a[2] * r * bf16_lo(gw.y), a[3] * r * bf16_hi(gw.y));
                w.z = pk_bf16(b[0] * r * bf16_lo(gw.z), b[1] * r * bf16_hi(gw.z)); w.w = pk_bf16(b[2] * r * bf16_lo(gw.w), b[3] * r * bf16_hi(gw.w));
                *(u32x4*)(mixin + (size_t)row * 1024 + c) = w;
            }
        } else if (EN(5) && s == 5) {
            pg8::Gemm g{(const bf16_t*)(ws + WS_MIXIN), (const bf16_t*)(wl + WL_OUT), D, D, 512};
            pg8::Order S; S.init(MPAD / 256, D / 256, G, bid, 2, 512, 1, (G == 256) ? DOWN_SPLIT : 0);
            EpiRes E{ws, 3 * l + 2, 13 + l, 1.0f};
            pg8::gemm_phase(lds, g, S, E, tid);
            if (S.nsplit > 0) { fin_ssn = 3 * l + 2; fin_ss5 = 13 + l; }
        }
        if (fin_ssn >= 0) { fast_grid_barrier((unsigned*)(ws + WS_BAR), ++kb, myx, nloc, nx, tid); finish_remainder(ws, fin_ssn, fin_ss5, bid, G, wave, lane); }
        fast_grid_barrier((unsigned*)(ws + WS_BAR), ++kb, myx, nloc, nx, tid);
    }
    {
        int tidf = TID_NOW(); asm volatile("" : "+v"(tidf));
        const int bid = bid0, G = G0; unsigned char* ws = launder(gws());
        const int wave = wave0, lane = tidf & 63;
        const float* ssf = (const float*)(ws + WS_SS) + (size_t)12 * MPAD * 16; const float* nf = gin(30); const float* h32 = (const float*)(ws + WS_H32);
        for (int row = bid * 8 + wave; row < M; row += G * 8) {
            float* dst;
            if (row < MPROMPT) { const int b = row / LP, pos = row - b * LP; if (pos < 16) continue; dst = gout() + O_YP + ((size_t)b * SEQ + pos - 16) * D; }
            else dst = gout() + O_YS + (size_t)(row - MPROMPT) * D;
            const float rs = rsqrtf(row_ss16(ssf, row) * (1.f / 1024.f) + EPS);
#pragma unroll
            for (int i = 0; i < 4; ++i) {
                const int c = (i * 64 + lane) * 4;
                const f32x4 v = *(const f32x4*)(h32 + (size_t)row * D + c), gn = *(const f32x4*)(nf + c);
                *(f32x4*)(dst + c) = v * rs * gn;
            }
        }
    }
}

extern "C" void kernel_launch(void* const* d_in, const int* in_sizes, int n_in, void* d_out, int out_size, void* d_ws, size_t ws_size, hipStream_t stream) {
    static int grid_blocks = 0;
    if (grid_blocks == 0) {
        int dev = 0, cus = 0, per_cu = 0;
        hipGetDevice(&dev);
        hipDeviceGetAttribute(&cus, hipDeviceAttributeMultiprocessorCount, dev);
        hipFuncSetAttribute((const void*)fwd_megakernel, hipFuncAttributeMaxDynamicSharedMemorySize, LDS_BYTES);
        hipOccupancyMaxActiveBlocksPerMultiprocessor(&per_cu, (const void*)fwd_megakernel, NTHREADS, LDS_BYTES);
        if (per_cu < 1) per_cu = 1;
        grid_blocks = cus;
        if (ws_size < WS_END) { fprintf(stderr, "kernel_launch: workspace too small: %zu < %zu\n", ws_size, (size_t)WS_END); grid_blocks = -1; }
        if (n_in != 31) fprintf(stderr, "kernel_launch: expected 31 inputs, got %d\n", n_in);
    }
    if (grid_blocks < 0) return;
    Params p{};
    for (int i = 0; i < 31; ++i) p.in[i] = (const float*)d_in[i];
    p.out = (float*)d_out; p.ws = (unsigned char*)d_ws;
    hipMemsetAsync((char*)d_ws + WS_BAR, 0, 8192, stream);
    void* args[] = {&p};
    hipError_t e = hipLaunchCooperativeKernel((const void*)fwd_megakernel, dim3(grid_blocks), dim3(NTHREADS), args, LDS_BYTES, stream);
    if (e != hipSuccess) fprintf(stderr, "cooperative launch failed: %s (grid %d)\n", hipGetErrorString(e), grid_blocks);
}
```

```cpp
#include <hip/hip_runtime.h>
#include <hip/hip_cooperative_groups.h>
#include <cstdio>
namespace cg = cooperative_groups;

#define LAS __attribute__((address_space(3)))
typedef unsigned short bf16_t;
typedef short bf16x8 __attribute__((ext_vector_type(8)));
typedef short bf16x4 __attribute__((ext_vector_type(4)));
typedef float f32x4 __attribute__((ext_vector_type(4)));
typedef float f32x2 __attribute__((ext_vector_type(2)));
typedef unsigned u32x4 __attribute__((ext_vector_type(4)));
typedef unsigned u32x2 __attribute__((ext_vector_type(2)));

constexpr int D = 1024, NB = 8, SEQ = 2048, LP = 2064, MPROMPT = NB * LP, M = 17024, MPAD = 17152;
constexpr int DEPTH = 4, FFN = 2816, FFN2 = 5632, INC = 2560;
constexpr float EPS = 1e-6f;
constexpr int NTHREADS = 512;
constexpr int LDS_BYTES = 131072;
#ifndef EN_MASK
#define EN_MASK 0x3F
#endif
#define EN(k) ((EN_MASK >> (k)) & 1)
#ifndef DOWN_SPLIT
#define DOWN_SPLIT 4
#endif
#ifndef KREP_UP
#define KREP_UP 1
#endif
#ifndef DUP_SLOT
#define DUP_SLOT -1
#endif

constexpr size_t O_YP = 0, O_YS = 16777216, O_HGP = O_YS + 524288, O_S5RP = O_HGP + 2097152, O_S5IP = O_S5RP + 65536,
                 O_HGS = O_S5IP + 65536, O_S5RS = O_HGS + 33554432, O_S5IS = O_S5RS + 1048576;

constexpr size_t SZ_WA = (size_t)FFN2 * D * 2, SZ_WD = (size_t)D * FFN * 2, SZ_WIN = (size_t)INC * D * 2, SZ_WGLU = 512 * 512 * 2, SZ_WOUT = (size_t)D * D * 2;
constexpr size_t WL_A1 = 0, WL_D1 = WL_A1 + SZ_WA, WL_A2 = WL_D1 + SZ_WD, WL_D2 = WL_A2 + SZ_WA, WL_IN = WL_D2 + SZ_WD, WL_GLU = WL_IN + SZ_WIN,
                 WL_OUT = WL_GLU + SZ_WGLU, WL_SZ = WL_OUT + SZ_WOUT;
constexpr size_t WS_W = 0;
constexpr size_t WS_H32 = WS_W + 4 * WL_SZ;
constexpr size_t WS_HB = WS_H32 + (size_t)MPAD * D * 4;
constexpr size_t WS_SS = WS_HB + (size_t)MPAD * D * 2;
constexpr size_t WS_LB = WS_SS + (size_t)17 * MPAD * 16 * 4;
constexpr size_t WS_ABAR = WS_LB + 8192;
constexpr size_t WS_BBT = WS_ABAR + 65536;
constexpr size_t WS_CT = WS_BBT + 524288;
constexpr size_t WS_MIX = WS_CT + 524288;
constexpr size_t R512 = (size_t)MPAD * 512 * 2;
constexpr size_t WS_QT = WS_MIX, WS_KT = WS_QT + R512, WS_KTT = WS_KT + R512, WS_VT = WS_KTT + R512, WS_GS = WS_VT + R512, WS_UB = WS_GS + R512,
                 WS_YG = WS_UB + R512, WS_ORAW = WS_YG + R512, WS_MIXIN = WS_ORAW + 2 * R512, WS_ADEC = WS_MIXIN + 2 * R512,
                 WS_ADECS = WS_ADEC + (size_t)(MPAD / 16) * 512 * 4, WS_BAR = WS_ADECS + 128 * 512 * 4, WS_PART = WS_BAR + 8192, WS_END = WS_PART + (size_t)12 * 4 * 256 * 256 * 4;
constexpr size_t WS_ACT = WS_MIX;
static_assert((size_t)MPAD * FFN * 2 <= WS_BAR - WS_MIX, "act alias");

struct Params { const float* in[31]; float* out; unsigned char* ws; };
typedef const __attribute__((address_space(4))) Params* KP;
__device__ __forceinline__ KP kargs() { KP q = (KP)__builtin_amdgcn_kernarg_segment_ptr(); asm volatile("" : "+s"(q)); return q; }
#define GAS __attribute__((address_space(1)))
template <class T> __device__ __forceinline__ T* as_global(T* q) { return (T*)(GAS T*)q; }
__device__ __forceinline__ unsigned char* launder(unsigned char* q) { GAS unsigned char* g = (GAS unsigned char*)q; asm volatile("" : "+s"(g)); return (unsigned char*)g; }
__device__ __forceinline__ const float* gin(int i) { return as_global(kargs()->in[i]); }
__device__ __forceinline__ float* gout() { return as_global(kargs()->out); }
__device__ __forceinline__ unsigned char* gws() { return as_global(kargs()->ws); }

typedef __bf16 bf16v2 __attribute__((ext_vector_type(2)));
__device__ __forceinline__ unsigned pk_bf16(float lo, float hi) { f32x2 v = {lo, hi}; bf16v2 b = __builtin_convertvector(v, bf16v2); return __builtin_bit_cast(unsigned, b); }
__device__ __forceinline__ bf16_t to_bf16(float x) { return (bf16_t)(pk_bf16(x, 0.f) & 0xffffu); }
__device__ __forceinline__ float bf16_lo(unsigned w) { return __uint_as_float(w << 16); }
__device__ __forceinline__ float bf16_hi(unsigned w) { return __uint_as_float(w & 0xffff0000u); }
__device__ __forceinline__ float frcp(float x) { return __builtin_amdgcn_rcpf(x); }
__device__ __forceinline__ float sigm(float x) { return frcp(1.f + __expf(-x)); }
__device__ __forceinline__ float silu(float x) { return x * sigm(x); }
__device__ __forceinline__ float gelu_tanh(float x) { return x * sigm(1.5957691216057308f * (x + 0.044715f * x * x * x)); }
template <int N> __device__ __forceinline__ float dpp_shr(float x) { return __int_as_float(__builtin_amdgcn_update_dpp(0, __float_as_int(x), 0x110 + N, 0xF, 0xF, true)); }
__device__ __forceinline__ float scan16(float x, bool sample, int fr) {
    float t = dpp_shr<1>(x); if (sample && (fr & 3) < 1) t = 0.f; x += t;
    t = dpp_shr<2>(x); if (sample && (fr & 3) < 2) t = 0.f; x += t;
    if (!sample) { x += dpp_shr<4>(x); x += dpp_shr<8>(x); }
    return x;
}
template <int N> __device__ __forceinline__ float dpp_shr1(float x) { return __int_as_float(__builtin_amdgcn_update_dpp(0x3f800000, __float_as_int(x), 0x110 + N, 0xF, 0xF, false)); }
__device__ __forceinline__ float cumprod16(float x, bool sample, int fr) {
    float t = dpp_shr1<1>(x); if (sample && (fr & 3) < 1) t = 1.f; x *= t;
    t = dpp_shr1<2>(x); if (sample && (fr & 3) < 2) t = 1.f; x *= t;
    if (!sample) { x *= dpp_shr1<4>(x); x *= dpp_shr1<8>(x); }
    return x;
}
__device__ __forceinline__ f32x4 mfma32(bf16x8 a, bf16x8 b, f32x4 c) { return __builtin_amdgcn_mfma_f32_16x16x32_bf16(a, b, c, 0, 0, 0); }
__device__ __forceinline__ f32x4 mfma16(bf16x4 a, bf16x4 b, f32x4 c) {
    const bf16x8 a8 = (bf16x8){a[0], a[1], a[2], a[3], 0, 0, 0, 0}, b8 = (bf16x8){b[0], b[1], b[2], b[3], 0, 0, 0, 0};
    return __builtin_amdgcn_mfma_f32_16x16x32_bf16(a8, b8, c, 0, 0, 0);
}
__device__ __forceinline__ float row_ss16(const float* base, int row) {
    const f32x4* q = (const f32x4*)(base + (size_t)row * 16);
    const f32x4 a = q[0], b = q[1], c = q[2], d = q[3];
    return ((a[0] + a[1]) + (a[2] + a[3])) + ((b[0] + b[1]) + (b[2] + b[3])) + ((c[0] + c[1]) + (c[2] + c[3])) + ((d[0] + d[1]) + (d[2] + d[3]));
}
__device__ __forceinline__ float row_ss8(const float* base, int row) {
    const f32x4* q = (const f32x4*)(base + (size_t)row * 16);
    const f32x4 a = q[0], b = q[1];
    return ((a[0] + a[1]) + (a[2] + a[3])) + ((b[0] + b[1]) + (b[2] + b[3]));
}
#define MFMA_FENCE() do { __builtin_amdgcn_sched_barrier(0); asm volatile("s_nop 15\n\ts_nop 15" ::: "memory"); __builtin_amdgcn_sched_barrier(0); } while (0)
#define LGKM0() asm volatile("s_waitcnt lgkmcnt(0)" ::: "memory")

namespace pg8 {
constexpr int BM = 256, BK = 64, HALF = 128, HTB = HALF * BK * 2, STAGE_BYTES = 8 * HTB, NXCD = 8, WGM = 8;
__device__ __forceinline__ int lds_byte(int r, int c) { const int st = (r >> 4) * 2 + (c >> 5), rr = r & 15, cc = c & 31, ob = rr * 64 + cc * 2; return st * 1024 + (ob ^ (((ob >> 9) & 1) << 5)); }
__device__ __forceinline__ void stage_rc(int b, int& R, int& C) { const int st = b / 1024, sb = b % 1024, swz = sb ^ (((sb >> 9) & 1) << 5); R = (st >> 1) * 16 + swz / 64; C = (st & 1) * 32 + (swz % 64) / 2; }

struct Unit { int pm, pn, kh, skip, k0, nt, part; };
struct Gemm { const bf16_t* A; const bf16_t* Bt; int lda, ldb, K; };
struct Order {
    int nM, nN, nwg, G, c, ks, rep, K, nsplit;
    __device__ void init(int nM_, int nN_, int G_, int c_, int ks_, int K_, int rep_ = 1, int nsplit_ = 0) { nM = nM_; nN = nN_; nwg = nM * nN; G = G_; c = c_; ks = ks_; rep = rep_; K = K_; nsplit = nsplit_; }
    __device__ void tile_of(int L, int& pm, int& pn) const {
        int wgid = L; { const int q = nwg / NXCD, r = nwg % NXCD, xcd = wgid % NXCD, off = wgid / NXCD; wgid = (xcd < r ? xcd * (q + 1) : r * (q + 1) + (xcd - r) * q) + off; }
        const int nig = WGM * nN, gid = wgid / nig, fm = gid * WGM, gsz = (nM - fm) < WGM ? (nM - fm) : WGM;
        pm = fm + ((wgid % nig) % gsz); pn = (wgid % nig) / gsz;
    }
    __device__ bool next(int i0, Unit& u) const {
        const int i = i0 / rep; u.skip = (i0 - i * rep) != rep - 1;
        if (nsplit > 0 && i >= ks) {
            if (i > ks) return false;
            const int L = G + c / nsplit; if (L >= nwg) return false;
            const int part = c - (c / nsplit) * nsplit, ntall = ks * K / BK;
            const int base = (ntall / nsplit) & ~1, extra = (ntall - base * nsplit) / 2;
            u.part = part; u.kh = c / nsplit; u.nt = base + (part < extra ? 2 : 0);
            u.k0 = (part * base + 2 * (part < extra ? part : extra)) * BK;
            tile_of(L, u.pm, u.pn); return true;
        }
        const int t = i / ks; u.kh = i - t * ks; u.part = -1; u.k0 = u.kh * K; u.nt = K / BK;
        const long L = (long)t * G + c; if (L >= nwg) return false;
        tile_of((int)L, u.pm, u.pn); return true;
    }
};

template <class Epi>
__device__ __forceinline__ void gemm_phase(LAS unsigned char* lds, const Gemm g, const Order& S, const Epi& E, int tid) {
    asm volatile("" : "+v"(tid));
    const int wid = __builtin_amdgcn_readfirstlane(tid >> 6), lane = tid & 63, wr = wid >> 2, wc = wid & 3, fr = lane & 15, fq = lane >> 4;
    unsigned voffA[2], voffB[2];
#pragma unroll
    for (int i = 0; i < 2; ++i) { int R, C; stage_rc(tid * 16 + i * 8192, R, C); voffA[i] = (unsigned)(R * g.lda + C) * 2u; voffB[i] = (unsigned)(R * g.ldb + C) * 2u; }
    const size_t kstep = (size_t)(BK * 2);
    const size_t hstepA = (size_t)HALF * g.lda * 2, hstepB = (size_t)HALF * g.ldb * 2;
    const size_t tstepA = 2 * hstepA, tstepB = 2 * hstepB;
    const unsigned ldsw = (unsigned)wid * 1024u;
    const int aoff = lds_byte(wr * 64 + fr, fq * 8), boff = lds_byte(wc * 32 + fr, fq * 8);
#define PG8_SA(b, h) (((b) * 2 + (h)) * HTB)
#define PG8_SB(b, h) ((4 + (b) * 2 + (h)) * HTB)
#define PG8_STAGE(bufoff, gbase, voff) do { _Pragma("unroll") for (int _i = 0; _i < 2; ++_i) \
        __builtin_amdgcn_global_load_lds((const unsigned*)((const char*)(gbase) + (voff)[_i]), (LAS unsigned*)(lds + (bufoff) + ldsw + _i * 8192), 16, 0, 0); } while (0)
#define PG8_LDA(dst, b, h) do { _Pragma("unroll") for (int m = 0; m < 4; ++m) _Pragma("unroll") for (int k = 0; k < 2; ++k) dst[m][k] = *(const LAS bf16x8*)(lds + PG8_SA(b, h) + aoff + m * 2048 + k * 1024); } while (0)
#define PG8_LDB(dst, b, h) do { _Pragma("unroll") for (int n = 0; n < 2; ++n) _Pragma("unroll") for (int k = 0; k < 2; ++k) dst[n][k] = *(const LAS bf16x8*)(lds + PG8_SB(b, h) + boff + n * 2048 + k * 1024); } while (0)
#define PG8_MMA(ai, bj, At, Bt) do { __builtin_amdgcn_s_setprio(1); _Pragma("unroll") for (int m = 0; m < 4; ++m) _Pragma("unroll") for (int n = 0; n < 2; ++n) _Pragma("unroll") for (int k = 0; k < 2; ++k) \
        acc[ai][bj][m][n] = __builtin_amdgcn_mfma_f32_16x16x32_bf16(Bt[n][k], At[m][k], acc[ai][bj][m][n], 0, 0, 0); __builtin_amdgcn_s_setprio(0); } while (0)
#define PG8_WAIT_V(n) asm volatile("s_waitcnt vmcnt(" #n ")" ::: "memory")
#define PG8_WAIT_L(n) asm volatile("s_waitcnt lgkmcnt(" #n ")" ::: "memory")
#define PG8_BAR __builtin_amdgcn_s_barrier()
#define PG8_SCHED __builtin_amdgcn_sched_barrier(0)
    Unit cur, nxt; int ui = 0;
    if (!S.next(0, cur)) return;
    f32x4 acc[2][2][4][2];
#pragma unroll
    for (int a = 0; a < 2; ++a)
#pragma unroll
        for (int b = 0; b < 2; ++b)
#pragma unroll
            for (int m = 0; m < 4; ++m)
#pragma unroll
                for (int n = 0; n < 2; ++n) acc[a][b][m][n] = (f32x4){0.f, 0.f, 0.f, 0.f};
    bf16x8 At[4][2], B0[2][2], B1[2][2];
    const char* cA = (const char*)g.A + (size_t)cur.pm * tstepA + (size_t)cur.k0 * 2;
    const char* cB = (const char*)g.Bt + (size_t)cur.pn * tstepB + (size_t)cur.k0 * 2;
    PG8_STAGE(PG8_SB(0, 0), cB, voffB); PG8_STAGE(PG8_SA(0, 0), cA, voffA); PG8_STAGE(PG8_SB(0, 1), cB + hstepB, voffB); PG8_STAGE(PG8_SA(0, 1), cA + hstepA, voffA);
    if (wr == 1) PG8_BAR;
    PG8_WAIT_V(4); PG8_BAR;
    PG8_STAGE(PG8_SB(1, 0), cB + kstep, voffB); PG8_STAGE(PG8_SA(1, 0), cA + kstep, voffA); PG8_STAGE(PG8_SB(1, 1), cB + hstepB + kstep, voffB);
    PG8_WAIT_V(6); PG8_BAR;
    for (;;) {
        const bool has_next = S.next(ui + 1, nxt);
        const char* nA = has_next ? (const char*)g.A + (size_t)nxt.pm * tstepA + (size_t)nxt.k0 * 2 : cA;
        const char* nB = has_next ? (const char*)g.Bt + (size_t)nxt.pn * tstepB + (size_t)nxt.k0 * 2 : cB;
        const int nt = cur.nt;
        for (int t = 0; t < nt; t += 2) {
            const bool last = (t == nt - 2);
            const char* a1 = cA + (size_t)(t + 1) * kstep;
            const char* a2 = last ? nA : cA + (size_t)(t + 2) * kstep; const char* b2 = last ? nB : cB + (size_t)(t + 2) * kstep;
            const char* a3 = a2 + kstep; const char* b3 = b2 + kstep;
            PG8_LDB(B0, 0, 0); PG8_SCHED; PG8_LDA(At, 0, 0); PG8_STAGE(PG8_SA(1, 1), a1 + hstepA, voffA);
            PG8_WAIT_L(8); PG8_BAR; PG8_WAIT_L(0); PG8_MMA(0, 0, At, B0); PG8_BAR; PG8_SCHED;
            PG8_LDB(B1, 0, 1); PG8_STAGE(PG8_SB(0, 0), b2, voffB);
            PG8_BAR; PG8_WAIT_L(0); PG8_MMA(0, 1, At, B1); PG8_BAR;
            PG8_LDA(At, 0, 1); PG8_STAGE(PG8_SA(0, 0), a2, voffA);
            PG8_BAR; PG8_WAIT_L(0); PG8_MMA(1, 0, At, B0); PG8_BAR; PG8_SCHED;
            PG8_STAGE(PG8_SB(0, 1), b2 + hstepB, voffB);
            PG8_WAIT_V(6); PG8_BAR; PG8_MMA(1, 1, At, B1); PG8_BAR;
            PG8_LDB(B0, 1, 0); PG8_SCHED; PG8_LDA(At, 1, 0); PG8_STAGE(PG8_SA(0, 1), a2 + hstepA, voffA);
            PG8_WAIT_L(8); PG8_BAR; PG8_WAIT_L(0); PG8_MMA(0, 0, At, B0); PG8_BAR; PG8_SCHED;
            PG8_LDB(B1, 1, 1); PG8_STAGE(PG8_SB(1, 0), b3, voffB);
            PG8_BAR; PG8_WAIT_L(0); PG8_MMA(0, 1, At, B1); PG8_BAR;
            PG8_LDA(At, 1, 1); PG8_STAGE(PG8_SA(1, 0), a3, voffA);
            PG8_BAR; PG8_WAIT_L(0); PG8_MMA(1, 0, At, B0); PG8_BAR; PG8_SCHED;
            PG8_STAGE(PG8_SB(1, 1), b3 + hstepB, voffB);
            PG8_WAIT_V(6); PG8_BAR; PG8_MMA(1, 1, At, B1); PG8_BAR;
        }
        MFMA_FENCE();
        if (!cur.skip) E(acc, cur, wr, wc, fr, fq);
        if (!has_next) break;
#pragma unroll
        for (int a = 0; a < 2; ++a)
#pragma unroll
            for (int b = 0; b < 2; ++b)
#pragma unroll
                for (int m = 0; m < 4; ++m)
#pragma unroll
                    for (int n = 0; n < 2; ++n) acc[a][b][m][n] = (f32x4){0.f, 0.f, 0.f, 0.f};
        cur = nxt; cA = nA; cB = nB; ++ui;
    }
    PG8_WAIT_V(0);
    if (wr == 0) PG8_BAR;
    PG8_BAR;
#undef PG8_SA
#undef PG8_SB
#undef PG8_STAGE
#undef PG8_LDA
#undef PG8_LDB
#undef PG8_MMA
#undef PG8_WAIT_V
#undef PG8_WAIT_L
#undef PG8_BAR
#undef PG8_SCHED
}
}
using pg8::Unit;

__device__ __forceinline__ void row_rstd8(float (&rs)[2][4], const float* ss, int rbase, int fq, int nslot4, float inv_n) {
    f32x4 p[2][4];
#pragma unroll
    for (int ai = 0; ai < 2; ++ai)
#pragma unroll
        for (int m = 0; m < 4; ++m) {
            p[ai][m] = (f32x4){0.f, 0.f, 0.f, 0.f};
            if (fq < nslot4) p[ai][m] = *(const f32x4*)(ss + (size_t)(rbase + ai * 128 + m * 16) * 16 + 4 * fq);
        }
#pragma unroll
    for (int ai = 0; ai < 2; ++ai)
#pragma unroll
        for (int m = 0; m < 4; ++m) {
            float t = (p[ai][m][0] + p[ai][m][1]) + (p[ai][m][2] + p[ai][m][3]);
            t += __shfl_xor(t, 16); t += __shfl_xor(t, 32);
            rs[ai][m] = rsqrtf(t * inv_n + EPS);
        }
}

struct EpiSwiglu {
    unsigned char* ws0; int ssi;
    __device__ __forceinline__ void operator()(const f32x4 (&acc)[2][2][4][2], const Unit& u, int wr, int wc, int fr, int fq) const {
        unsigned char* ws = launder(ws0);
        const float* ss = (const float*)(ws + WS_SS) + (size_t)ssi * MPAD * 16; bf16_t* act = (bf16_t*)(ws + WS_ACT);
        const int rbase = u.pm * 256 + wr * 64 + fr;
        float rsv[2][4]; row_rstd8(rsv, ss, rbase, fq, 4, 1.f / 1024.f);
#pragma unroll
        for (int ai = 0; ai < 2; ++ai)
#pragma unroll
            for (int m = 0; m < 4; ++m) {
                const int row = rbase + ai * 128 + m * 16;
                const float rs = rsv[ai][m];
#pragma unroll
                for (int bj = 0; bj < 2; ++bj) {
                    const f32x4 gv = acc[ai][bj][m][0] * rs, uv = acc[ai][bj][m][1] * rs;
                    const int oc = u.pn * 128 + bj * 64 + wc * 16 + 4 * fq;
                    u32x2 w; w.x = pk_bf16(silu(gv[0]) * uv[0], silu(gv[1]) * uv[1]); w.y = pk_bf16(silu(gv[2]) * uv[2], silu(gv[3]) * uv[3]);
                    *(u32x2*)(act + (size_t)row * FFN + oc) = w;
                }
            }
    }
};

struct EpiRes {
    unsigned char* ws0; int ssni, ss5i; float scale;
    __device__ __forceinline__ void operator()(const f32x4 (&acc)[2][2][4][2], const Unit& u, int wr, int wc, int fr, int fq) const {
        unsigned char* ws = launder(ws0);
        float* h32 = (float*)(ws + WS_H32); bf16_t* hb = (bf16_t*)(ws + WS_HB); float* ssn = (float*)(ws + WS_SS) + (size_t)ssni * MPAD * 16;
        const int rbase = u.pm * 256 + wr * 64 + fr;
        if (u.part >= 0) {
            int lo = (wr * 64 + fr) * 256 + wc * 32 + 4 * fq; asm volatile("" : "+v"(lo));
            float* pb = (float*)(ws + WS_PART) + (size_t)(u.kh * 4 + u.part) * 65536 + lo;
#pragma unroll
            for (int ai = 0; ai < 2; ++ai)
#pragma unroll
                for (int m = 0; m < 4; ++m)
#pragma unroll
                    for (int bj = 0; bj < 2; ++bj)
#pragma unroll
                        for (int n = 0; n < 2; ++n)
                            *(f32x4*)(pb + (ai * 128 + m * 16) * 256 + bj * 128 + n * 16) = acc[ai][bj][m][n] * scale;
            return;
        }
        const bool partial = (ss5i >= 0) && (u.kh == 0);
        float rsv[2][4];
        if (ss5i >= 0 && u.kh == 1) row_rstd8(rsv, (const float*)(ws + WS_SS) + (size_t)ss5i * MPAD * 16, rbase, fq, 2, 1.f / 512.f);
        else {
#pragma unroll
            for (int ai = 0; ai < 2; ++ai)
#pragma unroll
                for (int m = 0; m < 4; ++m) rsv[ai][m] = scale;
        }
#pragma unroll
        for (int ai = 0; ai < 2; ++ai) {
            f32x4 hv[4][2][2];
#pragma unroll
            for (int m = 0; m < 4; ++m)
#pragma unroll
                for (int bj = 0; bj < 2; ++bj)
#pragma unroll
                    for (int n = 0; n < 2; ++n)
                        hv[m][bj][n] = *(const f32x4*)(h32 + (size_t)(rbase + ai * 128 + m * 16) * D + u.pn * 256 + bj * 128 + wc * 32 + n * 16 + 4 * fq);
#pragma unroll
            for (int m = 0; m < 4; ++m) {
                const int row = rbase + ai * 128 + m * 16;
                const float sc = rsv[ai][m];
                float s = 0.f;
#pragma unroll
                for (int bj = 0; bj < 2; ++bj)
#pragma unroll
                    for (int n = 0; n < 2; ++n) {
                        const int c = u.pn * 256 + bj * 128 + wc * 32 + n * 16 + 4 * fq;
                        const f32x4 hn = hv[m][bj][n] + acc[ai][bj][m][n] * sc;
                        *(f32x4*)(h32 + (size_t)row * D + c) = hn;
                        if (!partial) {
                            u32x2 w; w.x = pk_bf16(hn[0], hn[1]); w.y = pk_bf16(hn[2], hn[3]);
                            *(u32x2*)(hb + (size_t)row * D + c) = w;
                            s += hn[0] * hn[0] + hn[1] * hn[1] + hn[2] * hn[2] + hn[3] * hn[3];
                        }
                    }
                if (!partial) {
                    s += __shfl_xor(s, 16); s += __shfl_xor(s, 32);
                    if (fq == 0) ssn[(size_t)row * 16 + u.pn * 4 + wc] = s;
                }
            }
        }
    }
};

struct EpiWin {
    unsigned char* ws0; int l;
    __device__ __forceinline__ void operator()(const f32x4 (&acc)[2][2][4][2], const Unit& u, int wr, int wc, int fr, int fq) const {
        unsigned char* ws = launder(ws0);
        const float* ss = (const float*)(ws + WS_SS) + (size_t)(3 * l + 1) * MPAD * 16; const float* lb = (const float*)(ws + WS_LB) + l * 512;
        bf16_t *qt = (bf16_t*)(ws + WS_QT), *kt = (bf16_t*)(ws + WS_KT), *ktT = (bf16_t*)(ws + WS_KTT), *vT = (bf16_t*)(ws + WS_VT), *gs = (bf16_t*)(ws + WS_GS), *ub = (bf16_t*)(ws + WS_UB);
        float *adec = (float*)(ws + WS_ADEC), *adecS = (float*)(ws + WS_ADECS);
        const int rbase = u.pm * 256 + wr * 64 + fr;
        float rsv[2][4]; row_rstd8(rsv, ss, rbase, fq, 4, 1.f / 1024.f);
        f32x4 lbv2[2];
#pragma unroll
        for (int bj = 0; bj < 2; ++bj) lbv2[bj] = *(const f32x4*)(lb + (u.pn & 3) * 128 + bj * 64 + wc * 16 + 4 * fq);
#pragma unroll
        for (int ai = 0; ai < 2; ++ai)
#pragma unroll
            for (int m = 0; m < 4; ++m) {
                const int row = rbase + ai * 128 + m * 16;
                const float rs = rsv[ai][m];
                const bool sample = (row - fr) >= MPROMPT;
                const size_t tb = (size_t)(row >> 4) * 512 * 16 + (row & 15);
                if (u.pn < 4) {
#pragma unroll
                    for (int bj = 0; bj < 2; ++bj) {
                        const int c0 = u.pn * 128 + bj * 64 + wc * 16 + 4 * fq;
                        const f32x4 lbv = lbv2[bj];
                        const f32x4 zq = acc[ai][bj][m][0] * rs, zf = acc[ai][bj][m][1] * rs;
                        f32x4 qv, kv, av;
#pragma unroll
                        for (int e = 0; e < 4; ++e) {
                            const float q = silu(zq[e]);
                            const float sg = sigm(zf[e]);
                            const float f = lbv[e] + (1.f - lbv[e]) * sg;
                            const float kk = (1.f - lbv[e]) * (1.f - sg);
                            const float eb = cumprod16(f, sample, fr);
                            qv[e] = q * eb; kv[e] = kk * frcp(fmaxf(eb, 1.8e-35f)); av[e] = eb;
                        }
                        u32x2 w; w.x = pk_bf16(qv[0], qv[1]); w.y = pk_bf16(qv[2], qv[3]);
                        *(u32x2*)(qt + (size_t)row * 512 + c0) = w;
                        w.x = pk_bf16(kv[0], kv[1]); w.y = pk_bf16(kv[2], kv[3]);
                        *(u32x2*)(kt + (size_t)row * 512 + c0) = w;
#pragma unroll
                        for (int e = 0; e < 4; ++e) ktT[tb + (size_t)(c0 + e) * 16] = to_bf16(kv[e]);
                        if (!sample) { if (fr == 15 && row < MPROMPT) *(f32x4*)(adec + (size_t)(row >> 4) * 512 + c0) = av; }
                        else { if ((fr & 3) == 3 && row < M) *(f32x4*)(adecS + (size_t)((row - MPROMPT) >> 2) * 512 + c0) = av; }
                    }
                } else {
#pragma unroll
                    for (int bj = 0; bj < 2; ++bj)
#pragma unroll
                        for (int n = 0; n < 2; ++n) {
                            const int c = (u.pn & 1) * 256 + bj * 128 + wc * 32 + n * 16 + 4 * fq;
                            const f32x4 v = acc[ai][bj][m][n] * rs;
                            if (u.pn < 6) {
#pragma unroll
                                for (int e = 0; e < 4; ++e) vT[tb + (size_t)(c + e) * 16] = to_bf16(v[e]);
                            } else if (u.pn < 8) {
                                u32x2 w; w.x = pk_bf16(silu(v[0]), silu(v[1])); w.y = pk_bf16(silu(v[2]), silu(v[3]));
                                *(u32x2*)(gs + (size_t)row * 512 + c) = w;
                            } else {
                                u32x2 w; w.x = pk_bf16(v[0], v[1]); w.y = pk_bf16(v[2], v[3]);
                                *(u32x2*)(ub + (size_t)row * 512 + c) = w;
                            }
                        }
                }
            }
    }
};

struct EpiGlu {
    unsigned char* ws0; int l;
    __device__ __forceinline__ void operator()(const f32x4 (&acc)[2][2][4][2], const Unit& u, int wr, int wc, int fr, int fq) const {
        unsigned char* ws = launder(ws0);
        const bf16_t* yg = (const bf16_t*)(ws + WS_YG); const float* bias = gin(23) + l * 512; bf16_t* mixin = (bf16_t*)(ws + WS_MIXIN);
        float* ss5 = (float*)(ws + WS_SS) + (size_t)(13 + l) * MPAD * 16;
        const int rbase = u.pm * 256 + wr * 64 + fr;
        f32x4 bv[2][2];
#pragma unroll
        for (int bj = 0; bj < 2; ++bj)
#pragma unroll
            for (int n = 0; n < 2; ++n) bv[bj][n] = *(const f32x4*)(bias + u.pn * 256 + bj * 128 + wc * 32 + n * 16 + 4 * fq);
#pragma unroll
        for (int ai = 0; ai < 2; ++ai) {
            u32x2 yw[4][2][2];
#pragma unroll
            for (int m = 0; m < 4; ++m)
#pragma unroll
                for (int bj = 0; bj < 2; ++bj)
#pragma unroll
                    for (int n = 0; n < 2; ++n)
                        yw[m][bj][n] = *(const u32x2*)(yg + (size_t)(rbase + ai * 128 + m * 16) * 512 + u.pn * 256 + bj * 128 + wc * 32 + n * 16 + 4 * fq);
#pragma unroll
            for (int m = 0; m < 4; ++m) {
                const int row = rbase + ai * 128 + m * 16;
                float s = 0.f;
#pragma unroll
                for (int bj = 0; bj < 2; ++bj)
#pragma unroll
                    for (int n = 0; n < 2; ++n) {
                        const int c = u.pn * 256 + bj * 128 + wc * 32 + n * 16 + 4 * fq;
                        const f32x4 a = acc[ai][bj][m][n] + bv[bj][n];
                        const u32x2 y2 = yw[m][bj][n];
                        f32x4 o;
                        o[0] = bf16_lo(y2.x) * sigm(a[0]); o[1] = bf16_hi(y2.x) * sigm(a[1]); o[2] = bf16_lo(y2.y) * sigm(a[2]); o[3] = bf16_hi(y2.y) * sigm(a[3]);
                        u32x2 w; w.x = pk_bf16(o[0], o[1]); w.y = pk_bf16(o[2], o[3]);
                        *(u32x2*)(mixin + (size_t)row * 1024 + 512 + c) = w;
                        s += o[0] * o[0] + o[1] * o[1] + o[2] * o[2] + o[3] * o[3];
                    }
                s += __shfl_xor(s, 16); s += __shfl_xor(s, 32);
                if (fq == 0) ss5[(size_t)row * 16 + u.pn * 4 + wc] = s;
            }
        }
    }
};

__device__ __forceinline__ void convert_tile(int t, LAS float* tile, int tid) {
    KP p = kargs(); (void)p;
    const int l = t / 2592; int r = t - l * 2592;
    const float *s0 = nullptr, *s1 = nullptr, *gn = nullptr, *gn2 = nullptr; int K, Nsrc, mode; size_t doff;
    if (r < 704) { mode = 0; s0 = gin(8) + (size_t)l * D * FFN; s1 = gin(9) + (size_t)l * D * FFN; gn = gin(7) + l * D; K = D; Nsrc = FFN; doff = WL_A1; }
    else if ((r -= 704) < 352) { mode = 1; s0 = gin(10) + (size_t)l * FFN * D; K = FFN; Nsrc = D; doff = WL_D1; }
    else if ((r -= 352) < 704) { mode = 0; s0 = gin(27) + (size_t)l * D * FFN; s1 = gin(28) + (size_t)l * D * FFN; gn = gin(26) + l * D; K = D; Nsrc = FFN; doff = WL_A2; }
    else if ((r -= 704) < 352) { mode = 1; s0 = gin(29) + (size_t)l * FFN * D; K = FFN; Nsrc = D; doff = WL_D2; }
    else if ((r -= 352) < 320) { mode = 2; s0 = gin(12) + (size_t)l * D * INC; gn = gin(11) + l * D; K = D; Nsrc = INC; doff = WL_IN; }
    else if ((r -= 320) < 32) { mode = 1; s0 = gin(22) + (size_t)l * 512 * 512; K = 512; Nsrc = 512; doff = WL_GLU; }
    else { r -= 32; mode = 3; s0 = gin(25) + (size_t)l * D * D; gn = gin(13) + l * 512; gn2 = gin(24) + l * 512; K = D; Nsrc = D; doff = WL_OUT; }
    bf16_t* dst = (bf16_t*)(gws() + WS_W + (size_t)l * WL_SZ + doff);
    const int nkt = K / 128, ntile = r / nkt, kt = r - ntile * nkt, n0 = ntile * 64, k0 = kt * 128;
    const int rr = tid & 63, np = n0 + rr;
    const float* src = s0; int col = np;
    if (mode == 0) { const int j = np >> 5, half = (np >> 4) & 1; col = 16 * j + (np & 15); src = half ? s1 : s0; }
    else if (mode == 2 && np < 1024) { const int j = np >> 5, half = (np >> 4) & 1, c = 16 * j + (np & 15); col = half ? 512 + c : c; }
    float v[16];
#pragma unroll
    for (int it = 0; it < 16; ++it) v[it] = src[(size_t)(k0 + (tid >> 6) + 8 * it) * Nsrc + col];
#pragma unroll
    for (int it = 0; it < 16; ++it) {
        const int kk = (tid >> 6) + 8 * it, k = k0 + kk;
        float x = v[it];
        if (mode == 0 || mode == 2) x *= gn[k];
        else if (mode == 3) x *= (k < 512 ? gn[k] : gn2[k - 512]);
        tile[kk * 65 + rr] = x;
    }
    __syncthreads();
    { const int r2 = tid >> 3, kc = tid & 7; float f[16];
#pragma unroll
      for (int j = 0; j < 16; ++j) f[j] = tile[(kc * 16 + j) * 65 + r2];
      u32x4 w0, w1; w0.x = pk_bf16(f[0], f[1]); w0.y = pk_bf16(f[2], f[3]); w0.z = pk_bf16(f[4], f[5]); w0.w = pk_bf16(f[6], f[7]);
      w1.x = pk_bf16(f[8], f[9]); w1.y = pk_bf16(f[10], f[11]); w1.z = pk_bf16(f[12], f[13]); w1.w = pk_bf16(f[14], f[15]);
      u32x4* dp = (u32x4*)(dst + (size_t)(n0 + r2) * K + k0 + kc * 16); dp[0] = w0; dp[1] = w1; }
    __syncthreads();
}
__device__ __forceinline__ void p0_init(LAS unsigned char* lds, int G, int bid, int tid) {
    const int wave = tid >> 6, lane = tid & 63;
    float* h32 = (float*)(gws() + WS_H32); bf16_t* hb = (bf16_t*)(gws() + WS_HB); float* ss = (float*)(gws() + WS_SS);
    for (int row = bid * 8 + wave; row < MPAD; row += G * 8) {
        const float* src = nullptr;
        if (row < MPROMPT) { const int b = row / LP, pos = row - b * LP; src = pos < 16 ? gin(5) + (size_t)pos * D : gin(0) + ((size_t)b * SEQ + pos - 16) * D; }
        else if (row < M) src = gin(1) + (size_t)(row - MPROMPT) * D;
        float s = 0.f;
#pragma unroll
        for (int i = 0; i < 4; ++i) {
            const int c = (i * 64 + lane) * 4;
            f32x4 v = (f32x4){0.f, 0.f, 0.f, 0.f};
            if (src) v = *(const f32x4*)(src + c);
            *(f32x4*)(h32 + (size_t)row * D + c) = v;
            u32x2 w; w.x = pk_bf16(v[0], v[1]); w.y = pk_bf16(v[2], v[3]);
            *(u32x2*)(hb + (size_t)row * D + c) = w;
            s += v[0] * v[0] + v[1] * v[1] + v[2] * v[2] + v[3] * v[3];
        }
#pragma unroll
        for (int o = 32; o > 0; o >>= 1) s += __shfl_xor(s, o);
        if (lane < 16) ss[(size_t)row * 16 + lane] = (lane == 0) ? s : 0.f;
    }
    const int gt = bid * NTHREADS + tid;
    if (gt < 512) {
        float v[4], mx = -1e30f;
        for (int l = 0; l < 4; ++l) { v[l] = gin(6)[l * 512 + gt]; mx = fmaxf(mx, v[l]); }
        float sum = 0.f; for (int l = 0; l < 4; ++l) { v[l] = expf(v[l] - mx); sum += v[l]; }
        float* lb = (float*)(gws() + WS_LB); float c = 0.f;
        for (int l = 0; l < 4; ++l) { lb[l * 512 + gt] = c; if (l < 3) c += v[l + 1] / sum; }
    }
    {
        const int i = gt - 512;
        if (i >= 0 && i < 4 * 32 * 64) {
            const int pidx = i & 63, lg = i >> 6;
            const float dt = expf(gin(16)[lg]);
            const float lr = fminf(gin(14)[i], -1e-4f), li = gin(15)[i];
            const float mag = expf(lr * dt), ar = mag * cosf(li * dt), ai = mag * sinf(li * dt);
            const float den = lr * lr + li * li;
            const float cr = ((ar - 1.f) * lr + ai * li) / den, ci = (ai * lr - (ar - 1.f) * li) / den;
            ((f32x2*)(gws() + WS_ABAR))[i] = (f32x2){ar, ai};
            bf16_t* bbT = (bf16_t*)(gws() + WS_BBT); bf16_t* cT = (bf16_t*)(gws() + WS_CT);
            for (int h = 0; h < 16; ++h) {
                const float br = gin(17)[(size_t)i * 16 + h], bi = gin(18)[(size_t)i * 16 + h];
                bbT[((size_t)lg * 128 + 2 * pidx) * 16 + h] = to_bf16(cr * br - ci * bi);
                bbT[((size_t)lg * 128 + 2 * pidx + 1) * 16 + h] = to_bf16(cr * bi + ci * br);
                cT[((size_t)lg * 16 + h) * 128 + 2 * pidx] = to_bf16(gin(19)[((size_t)lg * 16 + h) * 64 + pidx]);
                cT[((size_t)lg * 16 + h) * 128 + 2 * pidx + 1] = to_bf16(-gin(20)[((size_t)lg * 16 + h) * 64 + pidx]);
            }
        }
    }
    for (int t = bid; t < 4 * 2592; t += G) convert_tile(t, (LAS float*)lds, tid);
}

__device__ __forceinline__ void hgrn_core(const bf16x8 (&q)[4], const bf16x8 (&k)[4], const bf16x4 (&kT)[8], const bf16x4 v, const f32x4 (&av)[8],
                                          f32x4 (&S)[8], float* orow, f32x4& oout, bool sample, int fqm, int fr, int fq) {
    f32x4 sc = (f32x4){0.f, 0.f, 0.f, 0.f};
#pragma unroll
    for (int kk = 0; kk < 4; ++kk) sc = mfma32(k[kk], q[kk], sc);
    MFMA_FENCE();
#pragma unroll
    for (int i = 0; i < 4; ++i) { bool keep = (4 * fq + i) <= fr; if (sample) keep = keep && (fq == (fr >> 2)); sc[i] = keep ? sc[i] : 0.f; }
    u32x2 pw; pw.x = pk_bf16(sc[0], sc[1]); pw.y = pk_bf16(sc[2], sc[3]);
    f32x4 o = mfma16(__builtin_bit_cast(bf16x4, pw), v, (f32x4){0.f, 0.f, 0.f, 0.f});
#pragma unroll
    for (int kk = 0; kk < 4; ++kk) {
        u32x4 sb; sb.x = pk_bf16(S[2 * kk][0], S[2 * kk][1]); sb.y = pk_bf16(S[2 * kk][2], S[2 * kk][3]);
        sb.z = pk_bf16(S[2 * kk + 1][0], S[2 * kk + 1][1]); sb.w = pk_bf16(S[2 * kk + 1][2], S[2 * kk + 1][3]);
        o = mfma32(q[kk], __builtin_bit_cast(bf16x8, sb), o);
    }
    MFMA_FENCE();
    oout = o;
    if (orow != nullptr && (!sample || fq == fqm)) {
#pragma unroll
        for (int i = 0; i < 4; ++i) orow[(size_t)(4 * fq + i) * 512] = o[i];
    }
#pragma unroll
    for (int blk = 0; blk < 8; ++blk) {
        bf16x4 kt = kT[blk];
        if (sample && fq != fqm) kt = (bf16x4){0, 0, 0, 0};
        S[blk] = mfma16(kt, v, S[blk]);
    }
    MFMA_FENCE();
#pragma unroll
    for (int blk = 0; blk < 8; ++blk) S[blk] *= av[blk];
}
__device__ __forceinline__ void hgrn_sample_item(int l, int b, int h, int wave, int lane) {
    const int fr = lane & 15, fq = lane >> 4, cb = 128 * h, v0 = cb + 16 * wave;
    const bf16_t* qt = (const bf16_t*)(gws() + WS_QT); const bf16_t* kt = (const bf16_t*)(gws() + WS_KT);
    const bf16_t* ktT = (const bf16_t*)(gws() + WS_KTT); const bf16_t* vT = (const bf16_t*)(gws() + WS_VT);
    float* oraw = (float*)(gws() + WS_ORAW);
    const int R0 = MPROMPT + 4 * b, r0 = R0 & ~15, fqm = b & 3;
    f32x4 S[8];
    const float* s0 = gin(2) + (((size_t)l * 128 + b) * 4 + h) * 16384;
#pragma unroll
    for (int blk = 0; blk < 8; ++blk)
#pragma unroll
        for (int i = 0; i < 4; ++i) S[blk][i] = s0[(size_t)(16 * blk + 4 * fq + i) * 128 + 16 * wave + fr];
    bf16x8 q[4], k[4]; bf16x4 kT[8], v; f32x4 av[8];
    const size_t ro = (size_t)(r0 + fr) * 512 + cb + 4 * fq;
#pragma unroll
    for (int kk = 0; kk < 4; ++kk) {
        const u32x2 a0 = *(const u32x2*)(qt + ro + 32 * kk), a1 = *(const u32x2*)(qt + ro + 32 * kk + 16);
        const u32x2 b0 = *(const u32x2*)(kt + ro + 32 * kk), b1 = *(const u32x2*)(kt + ro + 32 * kk + 16);
        q[kk] = __builtin_bit_cast(bf16x8, ((u32x4){a0.x, a0.y, a1.x, a1.y})); k[kk] = __builtin_bit_cast(bf16x8, ((u32x4){b0.x, b0.y, b1.x, b1.y}));
    }
    const size_t to = (size_t)(r0 >> 4) * 512 * 16 + 4 * fq;
    const float* ap = (const float*)(gws() + WS_ADECS) + (size_t)b * 512 + cb + 4 * fq;
#pragma unroll
    for (int blk = 0; blk < 8; ++blk) { kT[blk] = *(const bf16x4*)(ktT + to + (size_t)(cb + 16 * blk + fr) * 16); av[blk] = *(const f32x4*)(ap + 16 * blk); }
    v = *(const bf16x4*)(vT + to + (size_t)(v0 + fr) * 16);
    f32x4 odummy;
    hgrn_core(q, k, kT, v, av, S, oraw + (size_t)r0 * 512 + v0 + fr, odummy, true, fqm, fr, fq);
    float* so = gout() + O_HGS + (((size_t)l * 128 + b) * 4 + h) * 16384;
#pragma unroll
    for (int blk = 0; blk < 8; ++blk)
#pragma unroll
        for (int i = 0; i < 4; ++i) so[(size_t)(16 * blk + 4 * fq + i) * 128 + 16 * wave + fr] = S[blk][i];
}
constexpr int HST = 16896, HNS = 7;
__device__ __forceinline__ void hgrn_issue(LAS unsigned char* lds, int ci, int row0, int cb, int wave, int lane) {
    const int cc = ci < 129 ? ci : 128, r0 = row0 + 16 * cc, chunk = r0 >> 4;
    LAS unsigned char* st = lds + (ci % HNS) * HST;
    const unsigned char* ws = gws();
    const int w4 = wave - 4, t = w4 * 64 + lane, row = t >> 4, c = (t & 15) ^ row;
    const size_t rowoff = ((size_t)(r0 + row) * 512 + cb + c * 8) * 2, toff = ((size_t)chunk * 512 + cb) * 32 + (size_t)t * 16;
    __builtin_amdgcn_global_load_lds((const unsigned*)(ws + WS_QT + rowoff), (LAS unsigned*)(st + w4 * 1024), 16, 0, 0);
    __builtin_amdgcn_global_load_lds((const unsigned*)(ws + WS_KT + rowoff), (LAS unsigned*)(st + 4096 + w4 * 1024), 16, 0, 0);
    __builtin_amdgcn_global_load_lds((const unsigned*)(ws + WS_KTT + toff), (LAS unsigned*)(st + 8192 + w4 * 1024), 16, 0, 0);
    __builtin_amdgcn_global_load_lds((const unsigned*)(ws + WS_VT + toff), (LAS unsigned*)(st + 12288 + w4 * 1024), 16, 0, 0);
    if (wave == 4 && lane < 32)
        __builtin_amdgcn_global_load_lds((const unsigned*)(ws + WS_ADEC + ((size_t)chunk * 512 + cb) * 4 + lane * 16), (LAS unsigned*)(st + 16384), 16, 0, 0);
}
__device__ __forceinline__ void hgrn_scores(LAS const unsigned char* st, LAS unsigned char* pb, int lane) {
    const int fr = lane & 15, fq = lane >> 4;
    f32x4 sc = (f32x4){0.f, 0.f, 0.f, 0.f};
#pragma unroll
    for (int kk = 0; kk < 4; ++kk) {
        const int e0 = 32 * kk + 4 * fq, e1 = e0 + 16;
        const int o0 = fr * 256 + (((e0 >> 3) ^ fr) << 4) + (e0 & 7) * 2, o1 = fr * 256 + (((e1 >> 3) ^ fr) << 4) + (e1 & 7) * 2;
        const u32x2 a0 = *(LAS const u32x2*)(st + o0), a1 = *(LAS const u32x2*)(st + o1);
        const u32x2 b0 = *(LAS const u32x2*)(st + 4096 + o0), b1 = *(LAS const u32x2*)(st + 4096 + o1);
        sc = mfma32(__builtin_bit_cast(bf16x8, ((u32x4){b0.x, b0.y, b1.x, b1.y})), __builtin_bit_cast(bf16x8, ((u32x4){a0.x, a0.y, a1.x, a1.y})), sc);
    }
    MFMA_FENCE();
#pragma unroll
    for (int i = 0; i < 4; ++i) sc[i] = ((4 * fq + i) <= fr) ? sc[i] : 0.f;
    u32x2 pw; pw.x = pk_bf16(sc[0], sc[1]); pw.y = pk_bf16(sc[2], sc[3]);
    *(LAS u32x2*)(pb + lane * 8) = pw;
}
__device__ __forceinline__ void hgrn_core_p(const bf16x8 (&q)[4], const bf16x4 P, const bf16x4 (&kT)[8], const bf16x4 v, const f32x4 (&av)[8], f32x4 (&S)[8], f32x4& oout) {
    f32x4 o = mfma16(P, v, (f32x4){0.f, 0.f, 0.f, 0.f});
#pragma unroll
    for (int kk = 0; kk < 4; ++kk) {
        u32x4 sb; sb.x = pk_bf16(S[2 * kk][0], S[2 * kk][1]); sb.y = pk_bf16(S[2 * kk][2], S[2 * kk][3]);
        sb.z = pk_bf16(S[2 * kk + 1][0], S[2 * kk + 1][1]); sb.w = pk_bf16(S[2 * kk + 1][2], S[2 * kk + 1][3]);
        o = mfma32(q[kk], __builtin_bit_cast(bf16x8, sb), o);
    }
#pragma unroll
    for (int blk = 0; blk < 8; ++blk) S[blk] = mfma16(kT[blk], v, S[blk]);
    MFMA_FENCE();
    oout = o;
#pragma unroll
    for (int blk = 0; blk < 8; ++blk) S[blk] *= av[blk];
}
__device__ __forceinline__ void hgrn_prompt_item(int l, int b, int h, int half, LAS unsigned char* lds, int tid, int wave, int lane) {
    const int fr = lane & 15, fq = lane >> 4, cb_ = 128 * h, vloc = 64 * half + 16 * (wave & 3), v0 = cb_ + vloc, row0 = b * LP;
    const bool comp = wave < 4;
    LAS unsigned char* pbuf = lds + HNS * HST;
    float* oraw = (float*)(gws() + WS_ORAW);
    f32x4 S[8];
#pragma unroll
    for (int blk = 0; blk < 8; ++blk) S[blk] = (f32x4){0.f, 0.f, 0.f, 0.f};
    if (!comp) {
        for (int ci = 0; ci < HNS - 1; ++ci) hgrn_issue(lds, ci, row0, cb_, wave, lane);
        if (wave == 4) asm volatile("s_waitcnt vmcnt(25)" ::: "memory"); else asm volatile("s_waitcnt vmcnt(20)" ::: "memory");
    }
    __builtin_amdgcn_s_barrier();
    asm volatile("" ::: "memory");
    if (wave == 5) { hgrn_scores(lds, pbuf, lane); LGKM0(); }
    f32x4 ob[4];
    for (int cb = 0; cb < 129; cb += 4) {
#pragma unroll
        for (int j = 0; j < 4; ++j) {
            const int ci = cb + j;
            if (ci < 129) {
                if (wave == 4) asm volatile("s_waitcnt vmcnt(20)" ::: "memory"); else if (wave > 4) asm volatile("s_waitcnt vmcnt(16)" ::: "memory");
                __builtin_amdgcn_s_barrier();
                asm volatile("" ::: "memory");
                if (comp) {
                    if (j == 0 && cb > 0) {
#pragma unroll
                        for (int jj = 0; jj < 4; ++jj)
#pragma unroll
                            for (int i = 0; i < 4; ++i) oraw[(size_t)(row0 + 16 * (cb - 4 + jj) + 4 * fq + i) * 512 + v0 + fr] = ob[jj][i];
                    }
                    LAS const unsigned char* st = lds + (ci % HNS) * HST;
                    bf16x8 q[4]; bf16x4 kT[8], v; f32x4 av[8];
#pragma unroll
                    for (int kk = 0; kk < 4; ++kk) {
                        const int e0 = 32 * kk + 4 * fq, e1 = e0 + 16;
                        const int o0 = fr * 256 + (((e0 >> 3) ^ fr) << 4) + (e0 & 7) * 2, o1 = fr * 256 + (((e1 >> 3) ^ fr) << 4) + (e1 & 7) * 2;
                        const u32x2 a0 = *(LAS const u32x2*)(st + o0), a1 = *(LAS const u32x2*)(st + o1);
                        q[kk] = __builtin_bit_cast(bf16x8, ((u32x4){a0.x, a0.y, a1.x, a1.y}));
                    }
#pragma unroll
                    for (int blk = 0; blk < 8; ++blk) {
                        kT[blk] = *(LAS const bf16x4*)(st + 8192 + (16 * blk + fr) * 32 + 8 * fq);
                        av[blk] = *(LAS const f32x4*)(st + 16384 + (16 * blk + 4 * fq) * 4);
                    }
                    v = *(LAS const bf16x4*)(st + 12288 + (vloc + fr) * 32 + 8 * fq);
                    const bf16x4 P = *(LAS const bf16x4*)(pbuf + (ci & 1) * 512 + lane * 8);
                    hgrn_core_p(q, P, kT, v, av, S, ob[j]);
                } else {
                    hgrn_issue(lds, ci + HNS - 1, row0, cb_, wave, lane);
                    if (wave == 5 && ci + 1 < 129) { hgrn_scores(lds + ((ci + 1) % HNS) * HST, pbuf + ((ci + 1) & 1) * 512, lane); LGKM0(); }
                }
            }
        }
    }
    if (comp) {
#pragma unroll
        for (int i = 0; i < 4; ++i) oraw[(size_t)(row0 + 16 * 128 + 4 * fq + i) * 512 + v0 + fr] = ob[0][i];
    }
    asm volatile("s_waitcnt vmcnt(0)" ::: "memory");
    __syncthreads();
    if (comp) {
        float* so = gout() + O_HGP + (((size_t)l * 8 + b) * 4 + h) * 16384;
#pragma unroll
        for (int blk = 0; blk < 8; ++blk)
#pragma unroll
            for (int i = 0; i < 4; ++i) so[(size_t)(16 * blk + 4 * fq + i) * 128 + vloc + fr] = S[blk][i];
    }
}

struct S5C { bf16x4 Bb[8]; bf16x8 Cf[4]; float ar, ai, dsk; };
__device__ __forceinline__ void s5_load_const(S5C& c, int l, int g, int lane) {
    const int fr = lane & 15, fq = lane >> 4, lg = l * 32 + g;
    const bf16_t* bbT = (const bf16_t*)(gws() + WS_BBT); const bf16_t* cT = (const bf16_t*)(gws() + WS_CT);
#pragma unroll
    for (int blk = 0; blk < 8; ++blk) c.Bb[blk] = *(const bf16x4*)(bbT + ((size_t)lg * 128 + 16 * blk + fr) * 16 + 4 * fq);
#pragma unroll
    for (int kk = 0; kk < 4; ++kk) c.Cf[kk] = *(const bf16x8*)(cT + ((size_t)lg * 16 + fr) * 128 + 32 * kk + 8 * fq);
    const f32x2 a = ((const f32x2*)(gws() + WS_ABAR))[lg * 64 + lane];
    c.ar = a.x; c.ai = a.y; c.dsk = gin(21)[lg * 16 + fr];
}
__device__ __forceinline__ bf16x4 s5_ua(const bf16_t* ub, int r0, int g, int fr, int fq) { return *(const bf16x4*)(ub + (size_t)(r0 + fr) * 512 + 16 * g + 4 * fq); }
__device__ __forceinline__ void s5_bu_v(const S5C& c, const bf16x4 ua, LAS float* bu, int fr, int fq);
__device__ __forceinline__ void s5_bu(const S5C& c, const bf16_t* ub, int r0, int g, LAS float* bu, int fr, int fq) { s5_bu_v(c, s5_ua(ub, r0, g, fr, fq), bu, fr, fq); }
__device__ __forceinline__ void s5_bu_v(const S5C& c, const bf16x4 ua, LAS float* bu, int fr, int fq) {
    f32x4 d[8];
#pragma unroll
    for (int blk = 0; blk < 8; ++blk) d[blk] = mfma16(ua, c.Bb[blk], (f32x4){0.f, 0.f, 0.f, 0.f});
    MFMA_FENCE();
#pragma unroll
    for (int blk = 0; blk < 8; ++blk)
#pragma unroll
        for (int i = 0; i < 4; ++i) bu[(4 * fq + i) * 132 + 16 * blk + fr] = d[blk][i];
}
__device__ __forceinline__ void s5_uu(unsigned (&uu)[4], const bf16_t* ub, int r0, int g, int fr, int fq) {
#pragma unroll
    for (int i = 0; i < 4; ++i) uu[i] = ub[(size_t)(r0 + 4 * fq + i) * 512 + 16 * g + fr];
}
__device__ __forceinline__ void s5_y(const S5C& c, const unsigned (&uu)[4], bf16_t* yg, int r0, int g, LAS const bf16_t* xs, int fr, int fq) {
    f32x4 y = (f32x4){0.f, 0.f, 0.f, 0.f};
#pragma unroll
    for (int kk = 0; kk < 4; ++kk) { const bf16x8 a = *(LAS const bf16x8*)(xs + fr * 136 + 32 * kk + 8 * fq); y = mfma32(a, c.Cf[kk], y); }
    MFMA_FENCE();
#pragma unroll
    for (int i = 0; i < 4; ++i) {
        const size_t o = (size_t)(r0 + 4 * fq + i) * 512 + 16 * g + fr;
        const float uf = __uint_as_float(uu[i] << 16);
        yg[o] = to_bf16(gelu_tanh(y[i] + c.dsk * uf));
    }
}
__device__ __forceinline__ void s5_prompt_item(int l, int b, int g, LAS unsigned char* lds, int wave, int lane) {
    const int fr = lane & 15, fq = lane >> 4;
    LAS float* bu = (LAS float*)(lds + wave * 12800); LAS bf16_t* xs = (LAS bf16_t*)(lds + wave * 12800 + 8448);
    LAS float* carr = (LAS float*)(lds + 8 * 12800);
    const bf16_t* ub = (const bf16_t*)(gws() + WS_UB); bf16_t* yg = (bf16_t*)(gws() + WS_YG);
    S5C c; s5_load_const(c, l, g, lane);
    const int c0 = 16 * wave, c1 = (wave == 7) ? 129 : 16 * wave + 16, row0 = b * LP;
#ifdef DIAG_NO_S5
    for (int ci = c0; ci < c1; ++ci) for (int i = 0; i < 4; ++i) yg[(size_t)(row0 + 16 * ci + 4 * fq + i) * 512 + 16 * g + fr] = 0;
    if (wave == 7) { const size_t o = (((size_t)l * 8 + b) * 32 + g) * 64 + lane; gout()[O_S5RP + o] = 0.f; gout()[O_S5IP + o] = 0.f; }
    return;
#endif
    float xr = 0.f, xi = 0.f;
    if (wave < 7) {
        bf16x4 ua_n = s5_ua(ub, row0 + 16 * c0, g, fr, fq);
        for (int ci = c0; ci < c1; ++ci) {
            const bf16x4 ua = ua_n;
            ua_n = s5_ua(ub, row0 + 16 * (ci + 1 < c1 ? ci + 1 : ci), g, fr, fq);
            s5_bu_v(c, ua, bu, fr, fq);
            LGKM0();
            f32x2 bv[16];
#pragma unroll
            for (int t = 0; t < 16; ++t) bv[t] = *(LAS const f32x2*)(bu + t * 132 + 2 * lane);
#pragma unroll
            for (int t = 0; t < 16; ++t) { const float nr = c.ar * xr - c.ai * xi + bv[t].x, ni = c.ar * xi + c.ai * xr + bv[t].y; xr = nr; xi = ni; }
            LGKM0();
        }
    }
    carr[(wave * 64 + lane) * 2] = xr; carr[(wave * 64 + lane) * 2 + 1] = xi;
    __syncthreads();
    float pr = c.ar, pi = c.ai;
#pragma unroll
    for (int s = 0; s < 8; ++s) { const float nr = pr * pr - pi * pi, ni = 2.f * pr * pi; pr = nr; pi = ni; }
    xr = 0.f; xi = 0.f;
    for (int w = 0; w < wave; ++w) {
        const float lr = carr[(w * 64 + lane) * 2], li = carr[(w * 64 + lane) * 2 + 1];
        const float nr = pr * xr - pi * xi + lr, ni = pr * xi + pi * xr + li; xr = nr; xi = ni;
    }
    bf16x4 ua_n = s5_ua(ub, row0 + 16 * c0, g, fr, fq); unsigned uu_n[4]; s5_uu(uu_n, ub, row0 + 16 * c0, g, fr, fq);
    for (int ci = c0; ci < c1; ++ci) {
        const int r0 = row0 + 16 * ci, rn = row0 + 16 * (ci + 1 < c1 ? ci + 1 : ci);
        const bf16x4 ua = ua_n; unsigned uu[4];
#pragma unroll
        for (int i = 0; i < 4; ++i) uu[i] = uu_n[i];
        ua_n = s5_ua(ub, rn, g, fr, fq); s5_uu(uu_n, ub, rn, g, fr, fq);
        s5_bu_v(c, ua, bu, fr, fq);
        LGKM0();
        f32x2 bv[16]; unsigned xp[16];
#pragma unroll
        for (int t = 0; t < 16; ++t) bv[t] = *(LAS const f32x2*)(bu + t * 132 + 2 * lane);
#pragma unroll
        for (int t = 0; t < 16; ++t) { const float nr = c.ar * xr - c.ai * xi + bv[t].x, ni = c.ar * xi + c.ai * xr + bv[t].y; xr = nr; xi = ni; xp[t] = pk_bf16(xr, xi); }
#pragma unroll
        for (int t = 0; t < 16; ++t) *(LAS unsigned*)(xs + t * 136 + 2 * lane) = xp[t];
        LGKM0();
        s5_y(c, uu, yg, r0, g, xs, fr, fq);
        LGKM0();
    }
    if (wave == 7) {
        const size_t o = (((size_t)l * 8 + b) * 32 + g) * 64 + lane;
        gout()[O_S5RP + o] = xr; gout()[O_S5IP + o] = xi;
    }
    __syncthreads();
}
__device__ __forceinline__ void s5_sample_wave(int l, int bblk, int g, LAS unsigned char* lds, int wave, int lane) {
    const int fr = lane & 15, fq = lane >> 4;
    LAS float* bu = (LAS float*)(lds + wave * 12800); LAS bf16_t* xs = (LAS bf16_t*)(lds + wave * 12800 + 8448);
    const bf16_t* ub = (const bf16_t*)(gws() + WS_UB); bf16_t* yg = (bf16_t*)(gws() + WS_YG);
    S5C c; s5_load_const(c, l, g, lane);
    const int r0 = MPROMPT + 16 * bblk;
#ifdef DIAG_NO_S5
    for (int i = 0; i < 4; ++i) yg[(size_t)(r0 + 4 * fq + i) * 512 + 16 * g + fr] = 0;
    for (int s = 0; s < 4; ++s) { const size_t o = (((size_t)l * 128 + 4 * bblk + s) * 32 + g) * 64 + lane; gout()[O_S5RS + o] = 0.f; gout()[O_S5IS + o] = 0.f; }
    return;
#endif
    unsigned uu[4]; s5_uu(uu, ub, r0, g, fr, fq);
    s5_bu(c, ub, r0, g, bu, fr, fq);
    LGKM0();
#pragma unroll
    for (int s = 0; s < 4; ++s) {
        const int b = 4 * bblk + s;
        const size_t o = (((size_t)l * 128 + b) * 32 + g) * 64 + lane;
        float xr = gin(3)[o], xi = gin(4)[o];
#pragma unroll
        for (int tt = 0; tt < 4; ++tt) {
            const int t = 4 * s + tt;
            const f32x2 bv = *(LAS const f32x2*)(bu + t * 132 + 2 * lane);
            const float nr = c.ar * xr - c.ai * xi + bv.x, ni = c.ar * xi + c.ai * xr + bv.y; xr = nr; xi = ni;
            *(LAS unsigned*)(xs + t * 136 + 2 * lane) = pk_bf16(xr, xi);
        }
        gout()[O_S5RS + o] = xr; gout()[O_S5IS + o] = xi;
    }
    LGKM0();
    s5_y(c, uu, yg, r0, g, xs, fr, fq);
    LGKM0();
}

#define BW_XCNT(x) (32 * (x))
#define BW_XSUB(x) (32 * (16 + (x)))
#define BW_XGEN(x) (32 * (32 + (x)))
#define BW_TOP (32 * 48)
#define BW_TOPGEN (32 * 49)
__device__ __forceinline__ unsigned bw_ld(unsigned* p) { return __hip_atomic_load(p, __ATOMIC_RELAXED, __HIP_MEMORY_SCOPE_AGENT); }
__device__ __forceinline__ unsigned bw_add(unsigned* p, unsigned v) { return __hip_atomic_fetch_add(p, v, __ATOMIC_RELAXED, __HIP_MEMORY_SCOPE_AGENT); }
__device__ __forceinline__ unsigned xcc_id() { return (unsigned)__builtin_amdgcn_s_getreg((3 << 11) | 20) & 0xFu; }
#define BW_SPIN(cond) do { unsigned _sp = 0; while (cond) { __builtin_amdgcn_s_sleep(1); if (++_sp > (1u << 22)) break; } } while (0)
__device__ __forceinline__ void fast_grid_barrier(unsigned* bar, unsigned k, unsigned x, unsigned nloc, unsigned nx, int tidnow) {
    asm volatile("s_waitcnt vmcnt(0) lgkmcnt(0)" ::: "memory");
    __syncthreads();
    if (tidnow == 0) {
        const unsigned old = bw_add(&bar[BW_XSUB(x)], 1u);
        if (old + 1u == k * nloc) {
            __builtin_amdgcn_fence(__ATOMIC_RELEASE, "agent");
            asm volatile("s_waitcnt vmcnt(0)" ::: "memory");
            const unsigned og = bw_add(&bar[BW_TOP], 1u);
            if (og + 1u == k * nx) bw_add(&bar[BW_TOPGEN], 1u);
            else BW_SPIN(bw_ld(&bar[BW_TOPGEN]) < k);
            __builtin_amdgcn_fence(__ATOMIC_ACQUIRE, "agent");
            bw_add(&bar[BW_XGEN(x)], 1u);
            asm volatile("s_waitcnt vmcnt(0)" ::: "memory");
        } else {
            BW_SPIN(bw_ld(&bar[BW_XGEN(x)]) < k);
            __builtin_amdgcn_fence(__ATOMIC_ACQUIRE, "agent");
            asm volatile("s_waitcnt vmcnt(0)" ::: "memory");
        }
    }
    __syncthreads();
}
__device__ __forceinline__ void finish_remainder(unsigned char* ws, int ssni, int ss5i, int bid, int G, int wave, int lane) {
    pg8::Order S; S.init(MPAD / 256, D / 256, G, bid, 1, 512);
    float* h32 = (float*)(ws + WS_H32); bf16_t* hbw = (bf16_t*)(ws + WS_HB);
    float* ssn = (float*)(ws + WS_SS) + (size_t)ssni * MPAD * 16;
    const int nrem = S.nwg - G;
    for (int task = bid * 8 + wave; task < nrem * 256; task += G * 8) {
        int pm, pn; S.tile_of(G + (task >> 8), pm, pn);
        const int row = pm * 256 + (task & 255), c = pn * 256 + lane * 4;
        f32x4 v = *(const f32x4*)(h32 + (size_t)row * D + c);
        const float* pb = (const float*)(ws + WS_PART) + (size_t)(task >> 8) * 4 * 65536 + (size_t)(task & 255) * 256 + lane * 4;
        const f32x4 p0 = *(const f32x4*)(pb), p1 = *(const f32x4*)(pb + 65536), p2 = *(const f32x4*)(pb + 2 * 65536), p3 = *(const f32x4*)(pb + 3 * 65536);
        float sc = 1.f;
        if (ss5i >= 0) sc = rsqrtf(row_ss8((const float*)(ws + WS_SS) + (size_t)ss5i * MPAD * 16, row) * (1.f / 512.f) + EPS);
        v += (p0 + p1) + (p2 + p3) * sc;
        *(f32x4*)(h32 + (size_t)row * D + c) = v;
        u32x2 w; w.x = pk_bf16(v[0], v[1]); w.y = pk_bf16(v[2], v[3]);
        *(u32x2*)(hbw + (size_t)row * D + c) = w;
        float sq = v[0] * v[0] + v[1] * v[1] + v[2] * v[2] + v[3] * v[3];
#pragma unroll
        for (int o = 32; o > 0; o >>= 1) sq += __shfl_xor(sq, o);
        if (lane < 4) ssn[(size_t)row * 16 + pn * 4 + lane] = (lane == 0) ? sq : 0.f;
    }
}
#define GRID_SYNC() do { asm volatile("s_waitcnt vmcnt(0) lgkmcnt(0)" ::: "memory"); grid.sync(); if (wave0 == 0) asm volatile("buffer_inv sc1\n\ts_waitcnt vmcnt(0)" ::: "memory"); __syncthreads(); } while (0)
__global__ void __launch_bounds__(NTHREADS, 2) fwd_megakernel(Params p) {
    extern __shared__ __attribute__((aligned(16))) unsigned char lds_raw[];
    LAS unsigned char* lds = (LAS unsigned char*)lds_raw;
    cg::grid_group grid = cg::this_grid();
    const int bid0 = blockIdx.x, G0 = gridDim.x;
    const int wave0 = __builtin_amdgcn_readfirstlane(threadIdx.x >> 6);
#define TID_NOW() ({ unsigned _m = ~0u; asm volatile("" : "+s"(_m)); wave0 * 64 + (int)__builtin_amdgcn_mbcnt_hi(_m, __builtin_amdgcn_mbcnt_lo(_m, 0u)); })

    const unsigned myx = xcc_id();
    if (threadIdx.x == 0) bw_add((unsigned*)(gws() + WS_BAR) + BW_XCNT(myx), 1u);
    p0_init(lds, G0, bid0, TID_NOW());
    GRID_SYNC();
    unsigned nloc = 0u, nx = 0u;
    { unsigned* bar = (unsigned*)(gws() + WS_BAR);
      for (unsigned j = 0; j < 16; ++j) { const unsigned c = bw_ld(&bar[BW_XCNT(j)]); nx += (c > 0u) ? 1u : 0u; nloc = (j == myx) ? c : nloc; }
      nloc = __builtin_amdgcn_readfirstlane(nloc); nx = __builtin_amdgcn_readfirstlane(nx); }

    unsigned kb = 0u;
    constexpr int NSLOT = (DUP_SLOT >= 0) ? 9 : 8;
    for (int step = 0; step < DEPTH * NSLOT; ++step) {
        const int l = step / NSLOT, s9 = step - l * NSLOT, s = (DUP_SLOT >= 0 && s9 > DUP_SLOT) ? s9 - 1 : s9;
        int bid = bid0, G = G0; asm volatile("" : "+s"(bid), "+s"(G));
        unsigned char* ws = launder(gws());
        const bf16_t* hb = (const bf16_t*)(ws + WS_HB); const bf16_t* act = (const bf16_t*)(ws + WS_ACT);
        int tid = TID_NOW(); asm volatile("" : "+v"(tid));
        const int wave = wave0, lane = tid & 63;
        unsigned char* wl = ws + WS_W + (size_t)l * WL_SZ;
        int fin_ssn = -1, fin_ss5 = -1;
        if (EN(0) && (s == 0 || s == 6)) {
            pg8::Gemm g{hb, (const bf16_t*)(wl + (s == 0 ? WL_A1 : WL_A2)), D, D, D};
            pg8::Order S; S.init(MPAD / 256, FFN2 / 256, G, bid, 1, D, KREP_UP);
            EpiSwiglu E{ws, 3 * l + (s == 0 ? 0 : 2)};
            pg8::gemm_phase(lds, g, S, E, tid);
        } else if (EN(1) && (s == 1 || s == 7)) {
            pg8::Gemm g{act, (const bf16_t*)(wl + (s == 1 ? WL_D1 : WL_D2)), FFN, FFN, FFN};
            pg8::Order S; S.init(MPAD / 256, D / 256, G, bid, 1, FFN, 1, (G == 256) ? DOWN_SPLIT : 0);
            EpiRes E{ws, 3 * l + (s == 1 ? 1 : 3), -1, 0.5f};
            pg8::gemm_phase(lds, g, S, E, tid);
            if (S.nsplit > 0) { fin_ssn = 3 * l + (s == 1 ? 1 : 3); fin_ss5 = -1; }
        } else if (EN(2) && s == 2) {
            pg8::Gemm g{hb, (const bf16_t*)(wl + WL_IN), D, D, D};
            pg8::Order S; S.init(MPAD / 256, INC / 256, G, bid, 1, D);
            EpiWin E{ws, l};
            pg8::gemm_phase(lds, g, S, E, tid);
        } else if (EN(3) && s == 3) {
            {
                if (bid < 64) hgrn_prompt_item(l, bid >> 3, (bid >> 1) & 3, bid & 1, lds, tid, wave, lane);
                else { for (int it = bid - 64; it < 256; it += G - 64) s5_prompt_item(l, it >> 5, it & 31, lds, wave, lane); }
                if (bid >= 64) {
                    for (int it = bid - 64; it < 640; it += G - 64) {
                        if (it < 512) hgrn_sample_item(l, it >> 2, it & 3, wave, lane);
                        else { const int wi = (it - 512) * 8 + wave; s5_sample_wave(l, wi >> 5, wi & 31, lds, wave, lane); }
                    }
                }
            }
        } else if (EN(4) && s == 4) {
            {
                pg8::Gemm g{(const bf16_t*)(ws + WS_YG), (const bf16_t*)(wl + WL_GLU), 512, 512, 512};
                pg8::Order S; S.init(MPAD / 256, 2, G, bid, 1, 512);
                EpiGlu E{ws, l};
                pg8::gemm_phase(lds, g, S, E, tid);
            }
            const float* oraw = (const float*)(ws + WS_ORAW); const bf16_t* gs = (const bf16_t*)(ws + WS_GS); bf16_t* mixin = (bf16_t*)(ws + WS_MIXIN);
            for (int row = bid * 8 + wave; row < M; row += G * 8) {
                const int c = lane * 8;
                const f32x4 a = *(const f32x4*)(oraw + (size_t)row * 512 + c), b = *(const f32x4*)(oraw + (size_t)row * 512 + c + 4);
                float sq = a[0] * a[0] + a[1] * a[1] + a[2] * a[2] + a[3] * a[3] + b[0] * b[0] + b[1] * b[1] + b[2] * b[2] + b[3] * b[3];
                sq += __shfl_xor(sq, 1); sq += __shfl_xor(sq, 2); sq += __shfl_xor(sq, 4); sq += __shfl_xor(sq, 8);
                const float r = rsqrtf(sq * (1.f / 128.f) + EPS);
                const u32x4 gw = *(const u32x4*)(gs + (size_t)row * 512 + c);
                u32x4 w;
                w.x = pk_bf16(a[0] * r * bf16_lo(gw.x), a[1] * r * bf16_hi(gw.x)); w.y = pk_bf16(a[2] * r * bf16_lo(gw.y), a[3] * r * bf16_hi(gw.y));
                w.z = pk_bf16(b[0] * r * bf16_lo(gw.z), b[1] * r * bf16_hi(gw.z)); w.w = pk_bf16(b[2] * r * bf16_lo(gw.w), b[3] * r * bf16_hi(gw.w));
                *(u32x4*)(mixin + (size_t)row * 1024 + c) = w;
            }
        } else if (EN(5) && s == 5) {
            pg8::Gemm g{(const bf16_t*)(ws + WS_MIXIN), (const bf16_t*)(wl + WL_OUT), D, D, 512};
            pg8::Order S; S.init(MPAD / 256, D / 256, G, bid, 2, 512, 1, (G == 256) ? DOWN_SPLIT : 0);
            EpiRes E{ws, 3 * l + 2, 13 + l, 1.0f};
            pg8::gemm_phase(lds, g, S, E, tid);
            if (S.nsplit > 0) { fin_ssn = 3 * l + 2; fin_ss5 = 13 + l; }
        }
        if (fin_ssn >= 0) { fast_grid_barrier((unsigned*)(ws + WS_BAR), ++kb, myx, nloc, nx, tid); finish_remainder(ws, fin_ssn, fin_ss5, bid, G, wave, lane); }
        fast_grid_barrier((unsigned*)(ws + WS_BAR), ++kb, myx, nloc, nx, tid);
    }
    {
        int tidf = TID_NOW(); asm volatile("" : "+v"(tidf));
        const int bid = bid0, G = G0; unsigned char* ws = launder(gws());
        const int wave = wave0, lane = tidf & 63;
        const float* ssf = (const float*)(ws + WS_SS) + (size_t)12 * MPAD * 16; const float* nf = gin(30); const float* h32 = (const float*)(ws + WS_H32);
        for (int row = bid * 8 + wave; row < M; row += G * 8) {
            float* dst;
            if (row < MPROMPT) { const int b = row / LP, pos = row - b * LP; if (pos < 16) continue; dst = gout() + O_YP + ((size_t)b * SEQ + pos - 16) * D; }
            else dst = gout() + O_YS + (size_t)(row - MPROMPT) * D;
            const float rs = rsqrtf(row_ss16(ssf, row) * (1.f / 1024.f) + EPS);
#pragma unroll
            for (int i = 0; i < 4; ++i) {
                const int c = (i * 64 + lane) * 4;
                const f32x4 v = *(const f32x4*)(h32 + (size_t)row * D + c), gn = *(const f32x4*)(nf + c);
                *(f32x4*)(dst + c) = v * rs * gn;
            }
        }
    }
}

extern "C" void kernel_launch(void* const* d_in, const int* in_sizes, int n_in, void* d_out, int out_size, void* d_ws, size_t ws_size, hipStream_t stream) {
    static int grid_blocks = 0;
    if (grid_blocks == 0) {
        int dev = 0, cus = 0, per_cu = 0;
        hipGetDevice(&dev);
        hipDeviceGetAttribute(&cus, hipDeviceAttributeMultiprocessorCount, dev);
        hipFuncSetAttribute((const void*)fwd_megakernel, hipFuncAttributeMaxDynamicSharedMemorySize, LDS_BYTES);
        hipOccupancyMaxActiveBlocksPerMultiprocessor(&per_cu, (const void*)fwd_megakernel, NTHREADS, LDS_BYTES);
        if (per_cu < 1) per_cu = 1;
        grid_blocks = cus;
        if (ws_size < WS_END) { fprintf(stderr, "kernel_launch: workspace too small: %zu < %zu\n", ws_size, (size_t)WS_END); grid_blocks = -1; }
        if (n_in != 31) fprintf(stderr, "kernel_launch: expected 31 inputs, got %d\n", n_in);
    }
    if (grid_blocks < 0) return;
    Params p{};
    for (int i = 0; i < 31; ++i) p.in[i] = (const float*)d_in[i];
    p.out = (float*)d_out; p.ws = (unsigned char*)d_ws;
    hipMemsetAsync((char*)d_ws + WS_BAR, 0, 8192, stream);
    void* args[] = {&p};
    hipError_t e = hipLaunchCooperativeKernel((const void*)fwd_megakernel, dim3(grid_blocks), dim3(NTHREADS), args, LDS_BYTES, stream);
    if (e != hipSuccess) fprintf(stderr, "cooperative launch failed: %s (grid %d)\n", hipGetErrorString(e), grid_blocks);
}
```

```cpp
#include <hip/hip_runtime.h>
#include <hip/hip_cooperative_groups.h>
#include <cstdio>
namespace cg = cooperative_groups;

#define LAS __attribute__((address_space(3)))
typedef unsigned short bf16_t;
typedef short bf16x8 __attribute__((ext_vector_type(8)));
typedef short bf16x4 __attribute__((ext_vector_type(4)));
typedef float f32x4 __attribute__((ext_vector_type(4)));
typedef float f32x2 __attribute__((ext_vector_type(2)));
typedef unsigned u32x4 __attribute__((ext_vector_type(4)));
typedef unsigned u32x2 __attribute__((ext_vector_type(2)));

constexpr int D = 1024, NB = 8, SEQ = 2048, LP = 2064, MPROMPT = NB * LP, M = 17024, MPAD = 17152;
constexpr int DEPTH = 4, FFN = 2816, FFN2 = 5632, INC = 2560;
constexpr float EPS = 1e-6f;
constexpr int NTHREADS = 512;
constexpr int LDS_BYTES = 131072;
#ifndef EN_MASK
#define EN_MASK 0x3F
#endif
#define EN(k) ((EN_MASK >> (k)) & 1)
#ifndef DOWN_SPLIT
#define DOWN_SPLIT 4
#endif
#ifndef KREP_UP
#define KREP_UP 1
#endif
#ifndef DUP_SLOT
#define DUP_SLOT -1
#endif

constexpr size_t O_YP = 0, O_YS = 16777216, O_HGP = O_YS + 524288, O_S5RP = O_HGP + 2097152, O_S5IP = O_S5RP + 65536,
                 O_HGS = O_S5IP + 65536, O_S5RS = O_HGS + 33554432, O_S5IS = O_S5RS + 1048576;

constexpr size_t SZ_WA = (size_t)FFN2 * D * 2, SZ_WD = (size_t)D * FFN * 2, SZ_WIN = (size_t)INC * D * 2, SZ_WGLU = 512 * 512 * 2, SZ_WOUT = (size_t)D * D * 2;
constexpr size_t WL_A1 = 0, WL_D1 = WL_A1 + SZ_WA, WL_A2 = WL_D1 + SZ_WD, WL_D2 = WL_A2 + SZ_WA, WL_IN = WL_D2 + SZ_WD, WL_GLU = WL_IN + SZ_WIN,
                 WL_OUT = WL_GLU + SZ_WGLU, WL_SZ = WL_OUT + SZ_WOUT;
constexpr size_t WS_W = 0;
constexpr size_t WS_H32 = WS_W + 4 * WL_SZ;
constexpr size_t WS_HB = WS_H32 + (size_t)MPAD * D * 4;
constexpr size_t WS_SS = WS_HB + (size_t)MPAD * D * 2;
constexpr size_t WS_LB = WS_SS + (size_t)17 * MPAD * 16 * 4;
constexpr size_t WS_ABAR = WS_LB + 8192;
constexpr size_t WS_BBT = WS_ABAR + 65536;
constexpr size_t WS_CT = WS_BBT + 524288;
constexpr size_t WS_MIX = WS_CT + 524288;
constexpr size_t R512 = (size_t)MPAD * 512 * 2;
constexpr size_t WS_QT = WS_MIX, WS_KT = WS_QT + R512, WS_KTT = WS_KT + R512, WS_VT = WS_KTT + R512, WS_GS = WS_VT + R512, WS_UB = WS_GS + R512,
                 WS_YG = WS_UB + R512, WS_ORAW = WS_YG + R512, WS_MIXIN = WS_ORAW + 2 * R512, WS_ADEC = WS_MIXIN + 2 * R512,
                 WS_ADECS = WS_ADEC + (size_t)(MPAD / 16) * 512 * 4, WS_BAR = WS_ADECS + 128 * 512 * 4, WS_PART = WS_BAR + 8192, WS_END = WS_PART + (size_t)12 * 4 * 256 * 256 * 4;
constexpr size_t WS_ACT = WS_MIX;
static_assert((size_t)MPAD * FFN * 2 <= WS_BAR - WS_MIX, "act alias");

struct Params { const float* in[31]; float* out; unsigned char* ws; };
typedef const __attribute__((address_space(4))) Params* KP;
__device__ __forceinline__ KP kargs() { KP q = (KP)__builtin_amdgcn_kernarg_segment_ptr(); asm volatile("" : "+s"(q)); return q; }
#define GAS __attribute__((address_space(1)))
template <class T> __device__ __forceinline__ T* as_global(T* q) { return (T*)(GAS T*)q; }
__device__ __forceinline__ unsigned char* launder(unsigned char* q) { GAS unsigned char* g = (GAS unsigned char*)q; asm volatile("" : "+s"(g)); return (unsigned char*)g; }
__device__ __forceinline__ const float* gin(int i) { return as_global(kargs()->in[i]); }
__device__ __forceinline__ float* gout() { return as_global(kargs()->out); }
__device__ __forceinline__ unsigned char* gws() { return as_global(kargs()->ws); }

typedef __bf16 bf16v2 __attribute__((ext_vector_type(2)));
__device__ __forceinline__ unsigned pk_bf16(float lo, float hi) { f32x2 v = {lo, hi}; bf16v2 b = __builtin_convertvector(v, bf16v2); return __builtin_bit_cast(unsigned, b); }
__device__ __forceinline__ bf16_t to_bf16(float x) { return (bf16_t)(pk_bf16(x, 0.f) & 0xffffu); }
__device__ __forceinline__ float bf16_lo(unsigned w) { return __uint_as_float(w << 16); }
__device__ __forceinline__ float bf16_hi(unsigned w) { return __uint_as_float(w & 0xffff0000u); }
__device__ __forceinline__ float frcp(float x) { return __builtin_amdgcn_rcpf(x); }
__device__ __forceinline__ float sigm(float x) { return frcp(1.f + __expf(-x)); }
__device__ __forceinline__ float silu(float x) { return x * sigm(x); }
__device__ __forceinline__ float gelu_tanh(float x) { return x * sigm(1.5957691216057308f * (x + 0.044715f * x * x * x)); }
template <int N> __device__ __forceinline__ float dpp_shr(float x) { return __int_as_float(__builtin_amdgcn_update_dpp(0, __float_as_int(x), 0x110 + N, 0xF, 0xF, true)); }
__device__ __forceinline__ float scan16(float x, bool sample, int fr) {
    float t = dpp_shr<1>(x); if (sample && (fr & 3) < 1) t = 0.f; x += t;
    t = dpp_shr<2>(x); if (sample && (fr & 3) < 2) t = 0.f; x += t;
    if (!sample) { x += dpp_shr<4>(x); x += dpp_shr<8>(x); }
    return x;
}
__device__ __forceinline__ f32x4 mfma32(bf16x8 a, bf16x8 b, f32x4 c) { return __builtin_amdgcn_mfma_f32_16x16x32_bf16(a, b, c, 0, 0, 0); }
__device__ __forceinline__ f32x4 mfma16(bf16x4 a, bf16x4 b, f32x4 c) {
    const bf16x8 a8 = (bf16x8){a[0], a[1], a[2], a[3], 0, 0, 0, 0}, b8 = (bf16x8){b[0], b[1], b[2], b[3], 0, 0, 0, 0};
    return __builtin_amdgcn_mfma_f32_16x16x32_bf16(a8, b8, c, 0, 0, 0);
}
__device__ __forceinline__ float row_ss16(const float* base, int row) {
    const f32x4* q = (const f32x4*)(base + (size_t)row * 16);
    const f32x4 a = q[0], b = q[1], c = q[2], d = q[3];
    return ((a[0] + a[1]) + (a[2] + a[3])) + ((b[0] + b[1]) + (b[2] + b[3])) + ((c[0] + c[1]) + (c[2] + c[3])) + ((d[0] + d[1]) + (d[2] + d[3]));
}
__device__ __forceinline__ float row_ss8(const float* base, int row) {
    const f32x4* q = (const f32x4*)(base + (size_t)row * 16);
    const f32x4 a = q[0], b = q[1];
    return ((a[0] + a[1]) + (a[2] + a[3])) + ((b[0] + b[1]) + (b[2] + b[3]));
}
#define MFMA_FENCE() do { __builtin_amdgcn_sched_barrier(0); asm volatile("s_nop 15\n\ts_nop 15" ::: "memory"); __builtin_amdgcn_sched_barrier(0); } while (0)
#define LGKM0() asm volatile("s_waitcnt lgkmcnt(0)" ::: "memory")

namespace pg8 {
constexpr int BM = 256, BK = 64, HALF = 128, HTB = HALF * BK * 2, STAGE_BYTES = 8 * HTB, NXCD = 8, WGM = 4;
__device__ __forceinline__ int lds_byte(int r, int c) { const int st = (r >> 4) * 2 + (c >> 5), rr = r & 15, cc = c & 31, ob = rr * 64 + cc * 2; return st * 1024 + (ob ^ (((ob >> 9) & 1) << 5)); }
__device__ __forceinline__ void stage_rc(int b, int& R, int& C) { const int st = b / 1024, sb = b % 1024, swz = sb ^ (((sb >> 9) & 1) << 5); R = (st >> 1) * 16 + swz / 64; C = (st & 1) * 32 + (swz % 64) / 2; }

struct Unit { int pm, pn, kh, skip, k0, nt, part; };
struct Gemm { const bf16_t* A; const bf16_t* Bt; int lda, ldb, K; };
struct Order {
    int nM, nN, nwg, G, c, ks, rep, K, nsplit;
    __device__ void init(int nM_, int nN_, int G_, int c_, int ks_, int K_, int rep_ = 1, int nsplit_ = 0) { nM = nM_; nN = nN_; nwg = nM * nN; G = G_; c = c_; ks = ks_; rep = rep_; K = K_; nsplit = nsplit_; }
    __device__ void tile_of(int L, int& pm, int& pn) const {
        int wgid = L; { const int q = nwg / NXCD, r = nwg % NXCD, xcd = wgid % NXCD, off = wgid / NXCD; wgid = (xcd < r ? xcd * (q + 1) : r * (q + 1) + (xcd - r) * q) + off; }
        const int nig = WGM * nN, gid = wgid / nig, fm = gid * WGM, gsz = (nM - fm) < WGM ? (nM - fm) : WGM;
        pm = fm + ((wgid % nig) % gsz); pn = (wgid % nig) / gsz;
    }
    __device__ bool next(int i0, Unit& u) const {
        const int i = i0 / rep; u.skip = (i0 - i * rep) != rep - 1;
        if (nsplit > 0 && i >= ks) {
            if (i > ks) return false;
            const int L = G + c / nsplit; if (L >= nwg) return false;
            const int part = c - (c / nsplit) * nsplit, ntall = ks * K / BK;
            const int base = (ntall / nsplit) & ~1, extra = (ntall - base * nsplit) / 2;
            u.part = part; u.kh = c / nsplit; u.nt = base + (part < extra ? 2 : 0);
            u.k0 = (part * base + 2 * (part < extra ? part : extra)) * BK;
            tile_of(L, u.pm, u.pn); return true;
        }
        const int t = i / ks; u.kh = i - t * ks; u.part = -1; u.k0 = u.kh * K; u.nt = K / BK;
        const long L = (long)t * G + c; if (L >= nwg) return false;
        tile_of((int)L, u.pm, u.pn); return true;
    }
};

template <class Epi>
__device__ __forceinline__ void gemm_phase(LAS unsigned char* lds, const Gemm g, const Order& S, const Epi& E, int tid) {
    asm volatile("" : "+v"(tid));
    const int wid = __builtin_amdgcn_readfirstlane(tid >> 6), lane = tid & 63, wr = wid >> 2, wc = wid & 3, fr = lane & 15, fq = lane >> 4;
    unsigned voffA[2], voffB[2];
#pragma unroll
    for (int i = 0; i < 2; ++i) { int R, C; stage_rc(tid * 16 + i * 8192, R, C); voffA[i] = (unsigned)(R * g.lda + C) * 2u; voffB[i] = (unsigned)(R * g.ldb + C) * 2u; }
    const size_t kstep = (size_t)(BK * 2);
    const size_t hstepA = (size_t)HALF * g.lda * 2, hstepB = (size_t)HALF * g.ldb * 2;
    const size_t tstepA = 2 * hstepA, tstepB = 2 * hstepB;
    const unsigned ldsw = (unsigned)wid * 1024u;
    const int aoff = lds_byte(wr * 64 + fr, fq * 8), boff = lds_byte(wc * 32 + fr, fq * 8);
#define PG8_SA(b, h) (((b) * 2 + (h)) * HTB)
#define PG8_SB(b, h) ((4 + (b) * 2 + (h)) * HTB)
#define PG8_STAGE(bufoff, gbase, voff) do { _Pragma("unroll") for (int _i = 0; _i < 2; ++_i) \
        __builtin_amdgcn_global_load_lds((const unsigned*)((const char*)(gbase) + (voff)[_i]), (LAS unsigned*)(lds + (bufoff) + ldsw + _i * 8192), 16, 0, 0); } while (0)
#define PG8_LDA(dst, b, h) do { _Pragma("unroll") for (int m = 0; m < 4; ++m) _Pragma("unroll") for (int k = 0; k < 2; ++k) dst[m][k] = *(const LAS bf16x8*)(lds + PG8_SA(b, h) + aoff + m * 2048 + k * 1024); } while (0)
#define PG8_LDB(dst, b, h) do { _Pragma("unroll") for (int n = 0; n < 2; ++n) _Pragma("unroll") for (int k = 0; k < 2; ++k) dst[n][k] = *(const LAS bf16x8*)(lds + PG8_SB(b, h) + boff + n * 2048 + k * 1024); } while (0)
#define PG8_MMA(ai, bj, At, Bt) do { __builtin_amdgcn_s_setprio(1); _Pragma("unroll") for (int m = 0; m < 4; ++m) _Pragma("unroll") for (int n = 0; n < 2; ++n) _Pragma("unroll") for (int k = 0; k < 2; ++k) \
        acc[ai][bj][m][n] = __builtin_amdgcn_mfma_f32_16x16x32_bf16(Bt[n][k], At[m][k], acc[ai][bj][m][n], 0, 0, 0); __builtin_amdgcn_s_setprio(0); } while (0)
#define PG8_WAIT_V(n) asm volatile("s_waitcnt vmcnt(" #n ")" ::: "memory")
#define PG8_WAIT_L(n) asm volatile("s_waitcnt lgkmcnt(" #n ")" ::: "memory")
#define PG8_BAR __builtin_amdgcn_s_barrier()
#define PG8_SCHED __builtin_amdgcn_sched_barrier(0)
    Unit cur, nxt; int ui = 0;
    if (!S.next(0, cur)) return;
    f32x4 acc[2][2][4][2];
#pragma unroll
    for (int a = 0; a < 2; ++a)
#pragma unroll
        for (int b = 0; b < 2; ++b)
#pragma unroll
            for (int m = 0; m < 4; ++m)
#pragma unroll
                for (int n = 0; n < 2; ++n) acc[a][b][m][n] = (f32x4){0.f, 0.f, 0.f, 0.f};
    bf16x8 At[4][2], B0[2][2], B1[2][2];
    const char* cA = (const char*)g.A + (size_t)cur.pm * tstepA + (size_t)cur.k0 * 2;
    const char* cB = (const char*)g.Bt + (size_t)cur.pn * tstepB + (size_t)cur.k0 * 2;
    PG8_STAGE(PG8_SB(0, 0), cB, voffB); PG8_STAGE(PG8_SA(0, 0), cA, voffA); PG8_STAGE(PG8_SB(0, 1), cB + hstepB, voffB); PG8_STAGE(PG8_SA(0, 1), cA + hstepA, voffA);
    if (wr == 1) PG8_BAR;
    PG8_WAIT_V(4); PG8_BAR;
    PG8_STAGE(PG8_SB(1, 0), cB + kstep, voffB); PG8_STAGE(PG8_SA(1, 0), cA + kstep, voffA); PG8_STAGE(PG8_SB(1, 1), cB + hstepB + kstep, voffB);
    PG8_WAIT_V(6); PG8_BAR;
    for (;;) {
        const bool has_next = S.next(ui + 1, nxt);
        const char* nA = has_next ? (const char*)g.A + (size_t)nxt.pm * tstepA + (size_t)nxt.k0 * 2 : cA;
        const char* nB = has_next ? (const char*)g.Bt + (size_t)nxt.pn * tstepB + (size_t)nxt.k0 * 2 : cB;
        const int nt = cur.nt;
        for (int t = 0; t < nt; t += 2) {
            const bool last = (t == nt - 2);
            const char* a1 = cA + (size_t)(t + 1) * kstep;
            const char* a2 = last ? nA : cA + (size_t)(t + 2) * kstep; const char* b2 = last ? nB : cB + (size_t)(t + 2) * kstep;
            const char* a3 = a2 + kstep; const char* b3 = b2 + kstep;
            PG8_LDB(B0, 0, 0); PG8_SCHED; PG8_LDA(At, 0, 0); PG8_STAGE(PG8_SA(1, 1), a1 + hstepA, voffA);
            PG8_WAIT_L(8); PG8_BAR; PG8_WAIT_L(0); PG8_MMA(0, 0, At, B0); PG8_BAR; PG8_SCHED;
            PG8_LDB(B1, 0, 1); PG8_STAGE(PG8_SB(0, 0), b2, voffB);
            PG8_BAR; PG8_WAIT_L(0); PG8_MMA(0, 1, At, B1); PG8_BAR;
            PG8_LDA(At, 0, 1); PG8_STAGE(PG8_SA(0, 0), a2, voffA);
            PG8_BAR; PG8_WAIT_L(0); PG8_MMA(1, 0, At, B0); PG8_BAR; PG8_SCHED;
            PG8_STAGE(PG8_SB(0, 1), b2 + hstepB, voffB);
            PG8_WAIT_V(6); PG8_BAR; PG8_MMA(1, 1, At, B1); PG8_BAR;
            PG8_LDB(B0, 1, 0); PG8_SCHED; PG8_LDA(At, 1, 0); PG8_STAGE(PG8_SA(0, 1), a2 + hstepA, voffA);
            PG8_WAIT_L(8); PG8_BAR; PG8_WAIT_L(0); PG8_MMA(0, 0, At, B0); PG8_BAR; PG8_SCHED;
            PG8_LDB(B1, 1, 1); PG8_STAGE(PG8_SB(1, 0), b3, voffB);
            PG8_BAR; PG8_WAIT_L(0); PG8_MMA(0, 1, At, B1); PG8_BAR;
            PG8_LDA(At, 1, 1); PG8_STAGE(PG8_SA(1, 0), a3, voffA);
            PG8_BAR; PG8_WAIT_L(0); PG8_MMA(1, 0, At, B0); PG8_BAR; PG8_SCHED;
            PG8_STAGE(PG8_SB(1, 1), b3 + hstepB, voffB);
            PG8_WAIT_V(6); PG8_BAR; PG8_MMA(1, 1, At, B1); PG8_BAR;
        }
        MFMA_FENCE();
        if (!cur.skip) E(acc, cur, wr, wc, fr, fq);
        if (!has_next) break;
#pragma unroll
        for (int a = 0; a < 2; ++a)
#pragma unroll
            for (int b = 0; b < 2; ++b)
#pragma unroll
                for (int m = 0; m < 4; ++m)
#pragma unroll
                    for (int n = 0; n < 2; ++n) acc[a][b][m][n] = (f32x4){0.f, 0.f, 0.f, 0.f};
        cur = nxt; cA = nA; cB = nB; ++ui;
    }
    PG8_WAIT_V(0);
    if (wr == 0) PG8_BAR;
    PG8_BAR;
#undef PG8_SA
#undef PG8_SB
#undef PG8_STAGE
#undef PG8_LDA
#undef PG8_LDB
#undef PG8_MMA
#undef PG8_WAIT_V
#undef PG8_WAIT_L
#undef PG8_BAR
#undef PG8_SCHED
}
}
using pg8::Unit;

__device__ __forceinline__ void row_rstd8(float (&rs)[2][4], const float* ss, int rbase, int fq, int nslot4, float inv_n) {
    f32x4 p[2][4];
#pragma unroll
    for (int ai = 0; ai < 2; ++ai)
#pragma unroll
        for (int m = 0; m < 4; ++m) {
            p[ai][m] = (f32x4){0.f, 0.f, 0.f, 0.f};
            if (fq < nslot4) p[ai][m] = *(const f32x4*)(ss + (size_t)(rbase + ai * 128 + m * 16) * 16 + 4 * fq);
        }
#pragma unroll
    for (int ai = 0; ai < 2; ++ai)
#pragma unroll
        for (int m = 0; m < 4; ++m) {
            float t = (p[ai][m][0] + p[ai][m][1]) + (p[ai][m][2] + p[ai][m][3]);
            t += __shfl_xor(t, 16); t += __shfl_xor(t, 32);
            rs[ai][m] = rsqrtf(t * inv_n + EPS);
        }
}

struct EpiSwiglu {
    unsigned char* ws0; int ssi;
    __device__ __forceinline__ void operator()(const f32x4 (&acc)[2][2][4][2], const Unit& u, int wr, int wc, int fr, int fq) const {
        unsigned char* ws = launder(ws0);
        const float* ss = (const float*)(ws + WS_SS) + (size_t)ssi * MPAD * 16; bf16_t* act = (bf16_t*)(ws + WS_ACT);
        const int rbase = u.pm * 256 + wr * 64 + fr;
        float rsv[2][4]; row_rstd8(rsv, ss, rbase, fq, 4, 1.f / 1024.f);
#pragma unroll
        for (int ai = 0; ai < 2; ++ai)
#pragma unroll
            for (int m = 0; m < 4; ++m) {
                const int row = rbase + ai * 128 + m * 16;
                const float rs = rsv[ai][m];
#pragma unroll
                for (int bj = 0; bj < 2; ++bj) {
                    const f32x4 gv = acc[ai][bj][m][0] * rs, uv = acc[ai][bj][m][1] * rs;
                    const int oc = u.pn * 128 + bj * 64 + wc * 16 + 4 * fq;
                    u32x2 w; w.x = pk_bf16(silu(gv[0]) * uv[0], silu(gv[1]) * uv[1]); w.y = pk_bf16(silu(gv[2]) * uv[2], silu(gv[3]) * uv[3]);
                    *(u32x2*)(act + (size_t)row * FFN + oc) = w;
                }
            }
    }
};

struct EpiRes {
    unsigned char* ws0; int ssni, ss5i; float scale;
    __device__ __forceinline__ void operator()(const f32x4 (&acc)[2][2][4][2], const Unit& u, int wr, int wc, int fr, int fq) const {
        unsigned char* ws = launder(ws0);
        float* h32 = (float*)(ws + WS_H32); bf16_t* hb = (bf16_t*)(ws + WS_HB); float* ssn = (float*)(ws + WS_SS) + (size_t)ssni * MPAD * 16;
        const int rbase = u.pm * 256 + wr * 64 + fr;
        if (u.part >= 0) {
            int lo = (wr * 64 + fr) * 256 + wc * 32 + 4 * fq; asm volatile("" : "+v"(lo));
            float* pb = (float*)(ws + WS_PART) + (size_t)(u.kh * 4 + u.part) * 65536 + lo;
#pragma unroll
            for (int ai = 0; ai < 2; ++ai)
#pragma unroll
                for (int m = 0; m < 4; ++m)
#pragma unroll
                    for (int bj = 0; bj < 2; ++bj)
#pragma unroll
                        for (int n = 0; n < 2; ++n)
                            *(f32x4*)(pb + (ai * 128 + m * 16) * 256 + bj * 128 + n * 16) = acc[ai][bj][m][n] * scale;
            return;
        }
        const bool partial = (ss5i >= 0) && (u.kh == 0);
        float rsv[2][4];
        if (ss5i >= 0 && u.kh == 1) row_rstd8(rsv, (const float*)(ws + WS_SS) + (size_t)ss5i * MPAD * 16, rbase, fq, 2, 1.f / 512.f);
        else {
#pragma unroll
            for (int ai = 0; ai < 2; ++ai)
#pragma unroll
                for (int m = 0; m < 4; ++m) rsv[ai][m] = scale;
        }
#pragma unroll
        for (int ai = 0; ai < 2; ++ai) {
            f32x4 hv[4][2][2];
#pragma unroll
            for (int m = 0; m < 4; ++m)
#pragma unroll
                for (int bj = 0; bj < 2; ++bj)
#pragma unroll
                    for (int n = 0; n < 2; ++n)
                        hv[m][bj][n] = *(const f32x4*)(h32 + (size_t)(rbase + ai * 128 + m * 16) * D + u.pn * 256 + bj * 128 + wc * 32 + n * 16 + 4 * fq);
#pragma unroll
            for (int m = 0; m < 4; ++m) {
                const int row = rbase + ai * 128 + m * 16;
                const float sc = rsv[ai][m];
                float s = 0.f;
#pragma unroll
                for (int bj = 0; bj < 2; ++bj)
#pragma unroll
                    for (int n = 0; n < 2; ++n) {
                        const int c = u.pn * 256 + bj * 128 + wc * 32 + n * 16 + 4 * fq;
                        const f32x4 hn = hv[m][bj][n] + acc[ai][bj][m][n] * sc;
                        *(f32x4*)(h32 + (size_t)row * D + c) = hn;
                        if (!partial) {
                            u32x2 w; w.x = pk_bf16(hn[0], hn[1]); w.y = pk_bf16(hn[2], hn[3]);
                            *(u32x2*)(hb + (size_t)row * D + c) = w;
                            s += hn[0] * hn[0] + hn[1] * hn[1] + hn[2] * hn[2] + hn[3] * hn[3];
                        }
                    }
                if (!partial) {
                    s += __shfl_xor(s, 16); s += __shfl_xor(s, 32);
                    if (fq == 0) ssn[(size_t)row * 16 + u.pn * 4 + wc] = s;
                }
            }
        }
    }
};

struct EpiWin {
    unsigned char* ws0; int l;
    __device__ __forceinline__ void operator()(const f32x4 (&acc)[2][2][4][2], const Unit& u, int wr, int wc, int fr, int fq) const {
        unsigned char* ws = launder(ws0);
        const float* ss = (const float*)(ws + WS_SS) + (size_t)(3 * l + 1) * MPAD * 16; const float* lb = (const float*)(ws + WS_LB) + l * 512;
        bf16_t *qt = (bf16_t*)(ws + WS_QT), *kt = (bf16_t*)(ws + WS_KT), *ktT = (bf16_t*)(ws + WS_KTT), *vT = (bf16_t*)(ws + WS_VT), *gs = (bf16_t*)(ws + WS_GS), *ub = (bf16_t*)(ws + WS_UB);
        float *adec = (float*)(ws + WS_ADEC), *adecS = (float*)(ws + WS_ADECS);
        const int rbase = u.pm * 256 + wr * 64 + fr;
        float rsv[2][4]; row_rstd8(rsv, ss, rbase, fq, 4, 1.f / 1024.f);
        f32x4 lbv2[2];
#pragma unroll
        for (int bj = 0; bj < 2; ++bj) lbv2[bj] = *(const f32x4*)(lb + (u.pn & 3) * 128 + bj * 64 + wc * 16 + 4 * fq);
#pragma unroll
        for (int ai = 0; ai < 2; ++ai)
#pragma unroll
            for (int m = 0; m < 4; ++m) {
                const int row = rbase + ai * 128 + m * 16;
                const float rs = rsv[ai][m];
                const bool sample = (row - fr) >= MPROMPT;
                const size_t tb = (size_t)(row >> 4) * 512 * 16 + (row & 15);
                if (u.pn < 4) {
#pragma unroll
                    for (int bj = 0; bj < 2; ++bj) {
                        const int c0 = u.pn * 128 + bj * 64 + wc * 16 + 4 * fq;
                        const f32x4 lbv = lbv2[bj];
                        const f32x4 zq = acc[ai][bj][m][0] * rs, zf = acc[ai][bj][m][1] * rs;
                        f32x4 qv, kv, av;
#pragma unroll
                        for (int e = 0; e < 4; ++e) {
                            const float q = silu(zq[e]);
                            const float sg = sigm(zf[e]);
                            const float f = lbv[e] + (1.f - lbv[e]) * sg;
                            const float lf = __logf(fmaxf(f, 1e-30f));
                            const float kk = (1.f - lbv[e]) * (1.f - sg);
                            const float b = scan16(lf, sample, fr);
                            qv[e] = q * __expf(b); kv[e] = kk * __expf(fminf(-b, 80.f)); av[e] = __expf(b);
                        }
                        u32x2 w; w.x = pk_bf16(qv[0], qv[1]); w.y = pk_bf16(qv[2], qv[3]);
                        *(u32x2*)(qt + (size_t)row * 512 + c0) = w;
                        w.x = pk_bf16(kv[0], kv[1]); w.y = pk_bf16(kv[2], kv[3]);
                        *(u32x2*)(kt + (size_t)row * 512 + c0) = w;
#pragma unroll
                        for (int e = 0; e < 4; ++e) ktT[tb + (size_t)(c0 + e) * 16] = to_bf16(kv[e]);
                        if (!sample) { if (fr == 15 && row < MPROMPT) *(f32x4*)(adec + (size_t)(row >> 4) * 512 + c0) = av; }
                        else { if ((fr & 3) == 3 && row < M) *(f32x4*)(adecS + (size_t)((row - MPROMPT) >> 2) * 512 + c0) = av; }
                    }
                } else {
#pragma unroll
                    for (int bj = 0; bj < 2; ++bj)
#pragma unroll
                        for (int n = 0; n < 2; ++n) {
                            const int c = (u.pn & 1) * 256 + bj * 128 + wc * 32 + n * 16 + 4 * fq;
                            const f32x4 v = acc[ai][bj][m][n] * rs;
                            if (u.pn < 6) {
#pragma unroll
                                for (int e = 0; e < 4; ++e) vT[tb + (size_t)(c + e) * 16] = to_bf16(v[e]);
                            } else if (u.pn < 8) {
                                u32x2 w; w.x = pk_bf16(silu(v[0]), silu(v[1])); w.y = pk_bf16(silu(v[2]), silu(v[3]));
                                *(u32x2*)(gs + (size_t)row * 512 + c) = w;
                            } else {
                                u32x2 w; w.x = pk_bf16(v[0], v[1]); w.y = pk_bf16(v[2], v[3]);
                                *(u32x2*)(ub + (size_t)row * 512 + c) = w;
                            }
                        }
                }
            }
    }
};

struct EpiGlu {
    unsigned char* ws0; int l;
    __device__ __forceinline__ void operator()(const f32x4 (&acc)[2][2][4][2], const Unit& u, int wr, int wc, int fr, int fq) const {
        unsigned char* ws = launder(ws0);
        const bf16_t* yg = (const bf16_t*)(ws + WS_YG); const float* bias = gin(23) + l * 512; bf16_t* mixin = (bf16_t*)(ws + WS_MIXIN);
        float* ss5 = (float*)(ws + WS_SS) + (size_t)(13 + l) * MPAD * 16;
        const int rbase = u.pm * 256 + wr * 64 + fr;
        f32x4 bv[2][2];
#pragma unroll
        for (int bj = 0; bj < 2; ++bj)
#pragma unroll
            for (int n = 0; n < 2; ++n) bv[bj][n] = *(const f32x4*)(bias + u.pn * 256 + bj * 128 + wc * 32 + n * 16 + 4 * fq);
#pragma unroll
        for (int ai = 0; ai < 2; ++ai) {
            u32x2 yw[4][2][2];
#pragma unroll
            for (int m = 0; m < 4; ++m)
#pragma unroll
                for (int bj = 0; bj < 2; ++bj)
#pragma unroll
                    for (int n = 0; n < 2; ++n)
                        yw[m][bj][n] = *(const u32x2*)(yg + (size_t)(rbase + ai * 128 + m * 16) * 512 + u.pn * 256 + bj * 128 + wc * 32 + n * 16 + 4 * fq);
#pragma unroll
            for (int m = 0; m < 4; ++m) {
                const int row = rbase + ai * 128 + m * 16;
                float s = 0.f;
#pragma unroll
                for (int bj = 0; bj < 2; ++bj)
#pragma unroll
                    for (int n = 0; n < 2; ++n) {
                        const int c = u.pn * 256 + bj * 128 + wc * 32 + n * 16 + 4 * fq;
                        const f32x4 a = acc[ai][bj][m][n] + bv[bj][n];
                        const u32x2 y2 = yw[m][bj][n];
                        f32x4 o;
                        o[0] = bf16_lo(y2.x) * sigm(a[0]); o[1] = bf16_hi(y2.x) * sigm(a[1]); o[2] = bf16_lo(y2.y) * sigm(a[2]); o[3] = bf16_hi(y2.y) * sigm(a[3]);
                        u32x2 w; w.x = pk_bf16(o[0], o[1]); w.y = pk_bf16(o[2], o[3]);
                        *(u32x2*)(mixin + (size_t)row * 1024 + 512 + c) = w;
                        s += o[0] * o[0] + o[1] * o[1] + o[2] * o[2] + o[3] * o[3];
                    }
                s += __shfl_xor(s, 16); s += __shfl_xor(s, 32);
                if (fq == 0) ss5[(size_t)row * 16 + u.pn * 4 + wc] = s;
            }
        }
    }
};

__device__ __forceinline__ void convert_tile(int t, LAS float* tile, int tid) {
    KP p = kargs(); (void)p;
    const int l = t / 2592; int r = t - l * 2592;
    const float *s0 = nullptr, *s1 = nullptr, *gn = nullptr, *gn2 = nullptr; int K, Nsrc, mode; size_t doff;
    if (r < 704) { mode = 0; s0 = gin(8) + (size_t)l * D * FFN; s1 = gin(9) + (size_t)l * D * FFN; gn = gin(7) + l * D; K = D; Nsrc = FFN; doff = WL_A1; }
    else if ((r -= 704) < 352) { mode = 1; s0 = gin(10) + (size_t)l * FFN * D; K = FFN; Nsrc = D; doff = WL_D1; }
    else if ((r -= 352) < 704) { mode = 0; s0 = gin(27) + (size_t)l * D * FFN; s1 = gin(28) + (size_t)l * D * FFN; gn = gin(26) + l * D; K = D; Nsrc = FFN; doff = WL_A2; }
    else if ((r -= 704) < 352) { mode = 1; s0 = gin(29) + (size_t)l * FFN * D; K = FFN; Nsrc = D; doff = WL_D2; }
    else if ((r -= 352) < 320) { mode = 2; s0 = gin(12) + (size_t)l * D * INC; gn = gin(11) + l * D; K = D; Nsrc = INC; doff = WL_IN; }
    else if ((r -= 320) < 32) { mode = 1; s0 = gin(22) + (size_t)l * 512 * 512; K = 512; Nsrc = 512; doff = WL_GLU; }
    else { r -= 32; mode = 3; s0 = gin(25) + (size_t)l * D * D; gn = gin(13) + l * 512; gn2 = gin(24) + l * 512; K = D; Nsrc = D; doff = WL_OUT; }
    bf16_t* dst = (bf16_t*)(gws() + WS_W + (size_t)l * WL_SZ + doff);
    const int nkt = K / 128, ntile = r / nkt, kt = r - ntile * nkt, n0 = ntile * 64, k0 = kt * 128;
    const int rr = tid & 63, np = n0 + rr;
    const float* src = s0; int col = np;
    if (mode == 0) { const int j = np >> 5, half = (np >> 4) & 1; col = 16 * j + (np & 15); src = half ? s1 : s0; }
    else if (mode == 2 && np < 1024) { const int j = np >> 5, half = (np >> 4) & 1, c = 16 * j + (np & 15); col = half ? 512 + c : c; }
    float v[16];
#pragma unroll
    for (int it = 0; it < 16; ++it) v[it] = src[(size_t)(k0 + (tid >> 6) + 8 * it) * Nsrc + col];
#pragma unroll
    for (int it = 0; it < 16; ++it) {
        const int kk = (tid >> 6) + 8 * it, k = k0 + kk;
        float x = v[it];
        if (mode == 0 || mode == 2) x *= gn[k];
        else if (mode == 3) x *= (k < 512 ? gn[k] : gn2[k - 512]);
        tile[kk * 65 + rr] = x;
    }
    __syncthreads();
    { const int r2 = tid >> 3, kc = tid & 7; float f[16];
#pragma unroll
      for (int j = 0; j < 16; ++j) f[j] = tile[(kc * 16 + j) * 65 + r2];
      u32x4 w0, w1; w0.x = pk_bf16(f[0], f[1]); w0.y = pk_bf16(f[2], f[3]); w0.z = pk_bf16(f[4], f[5]); w0.w = pk_bf16(f[6], f[7]);
      w1.x = pk_bf16(f[8], f[9]); w1.y = pk_bf16(f[10], f[11]); w1.z = pk_bf16(f[12], f[13]); w1.w = pk_bf16(f[14], f[15]);
      u32x4* dp = (u32x4*)(dst + (size_t)(n0 + r2) * K + k0 + kc * 16); dp[0] = w0; dp[1] = w1; }
    __syncthreads();
}
__device__ __forceinline__ void p0_init(LAS unsigned char* lds, int G, int bid, int tid) {
    const int wave = tid >> 6, lane = tid & 63;
    float* h32 = (float*)(gws() + WS_H32); bf16_t* hb = (bf16_t*)(gws() + WS_HB); float* ss = (float*)(gws() + WS_SS);
    for (int row = bid * 8 + wave; row < MPAD; row += G * 8) {
        const float* src = nullptr;
        if (row < MPROMPT) { const int b = row / LP, pos = row - b * LP; src = pos < 16 ? gin(5) + (size_t)pos * D : gin(0) + ((size_t)b * SEQ + pos - 16) * D; }
        else if (row < M) src = gin(1) + (size_t)(row - MPROMPT) * D;
        float s = 0.f;
#pragma unroll
        for (int i = 0; i < 4; ++i) {
            const int c = (i * 64 + lane) * 4;
            f32x4 v = (f32x4){0.f, 0.f, 0.f, 0.f};
            if (src) v = *(const f32x4*)(src + c);
            *(f32x4*)(h32 + (size_t)row * D + c) = v;
            u32x2 w; w.x = pk_bf16(v[0], v[1]); w.y = pk_bf16(v[2], v[3]);
            *(u32x2*)(hb + (size_t)row * D + c) = w;
            s += v[0] * v[0] + v[1] * v[1] + v[2] * v[2] + v[3] * v[3];
        }
#pragma unroll
        for (int o = 32; o > 0; o >>= 1) s += __shfl_xor(s, o);
        if (lane < 16) ss[(size_t)row * 16 + lane] = (lane == 0) ? s : 0.f;
    }
    const int gt = bid * NTHREADS + tid;
    if (gt < 512) {
        float v[4], mx = -1e30f;
        for (int l = 0; l < 4; ++l) { v[l] = gin(6)[l * 512 + gt]; mx = fmaxf(mx, v[l]); }
        float sum = 0.f; for (int l = 0; l < 4; ++l) { v[l] = expf(v[l] - mx); sum += v[l]; }
        float* lb = (float*)(gws() + WS_LB); float c = 0.f;
        for (int l = 0; l < 4; ++l) { lb[l * 512 + gt] = c; if (l < 3) c += v[l + 1] / sum; }
    }
    {
        const int i = gt - 512;
        if (i >= 0 && i < 4 * 32 * 64) {
            const int pidx = i & 63, lg = i >> 6;
            const float dt = expf(gin(16)[lg]);
            const float lr = fminf(gin(14)[i], -1e-4f), li = gin(15)[i];
            const float mag = expf(lr * dt), ar = mag * cosf(li * dt), ai = mag * sinf(li * dt);
            const float den = lr * lr + li * li;
            const float cr = ((ar - 1.f) * lr + ai * li) / den, ci = (ai * lr - (ar - 1.f) * li) / den;
            ((f32x2*)(gws() + WS_ABAR))[i] = (f32x2){ar, ai};
            bf16_t* bbT = (bf16_t*)(gws() + WS_BBT); bf16_t* cT = (bf16_t*)(gws() + WS_CT);
            for (int h = 0; h < 16; ++h) {
                const float br = gin(17)[(size_t)i * 16 + h], bi = gin(18)[(size_t)i * 16 + h];
                bbT[((size_t)lg * 128 + 2 * pidx) * 16 + h] = to_bf16(cr * br - ci * bi);
                bbT[((size_t)lg * 128 + 2 * pidx + 1) * 16 + h] = to_bf16(cr * bi + ci * br);
                cT[((size_t)lg * 16 + h) * 128 + 2 * pidx] = to_bf16(gin(19)[((size_t)lg * 16 + h) * 64 + pidx]);
                cT[((size_t)lg * 16 + h) * 128 + 2 * pidx + 1] = to_bf16(-gin(20)[((size_t)lg * 16 + h) * 64 + pidx]);
            }
        }
    }
    for (int t = bid; t < 4 * 2592; t += G) convert_tile(t, (LAS float*)lds, tid);
}

__device__ __forceinline__ void hgrn_core(const bf16x8 (&q)[4], const bf16x8 (&k)[4], const bf16x4 (&kT)[8], const bf16x4 v, const f32x4 (&av)[8],
                                          f32x4 (&S)[8], float* orow, f32x4& oout, bool sample, int fqm, int fr, int fq) {
    f32x4 sc = (f32x4){0.f, 0.f, 0.f, 0.f};
#pragma unroll
    for (int kk = 0; kk < 4; ++kk) sc = mfma32(k[kk], q[kk], sc);
    MFMA_FENCE();
#pragma unroll
    for (int i = 0; i < 4; ++i) { bool keep = (4 * fq + i) <= fr; if (sample) keep = keep && (fq == (fr >> 2)); sc[i] = keep ? sc[i] : 0.f; }
    u32x2 pw; pw.x = pk_bf16(sc[0], sc[1]); pw.y = pk_bf16(sc[2], sc[3]);
    f32x4 o = mfma16(__builtin_bit_cast(bf16x4, pw), v, (f32x4){0.f, 0.f, 0.f, 0.f});
#pragma unroll
    for (int kk = 0; kk < 4; ++kk) {
        u32x4 sb; sb.x = pk_bf16(S[2 * kk][0], S[2 * kk][1]); sb.y = pk_bf16(S[2 * kk][2], S[2 * kk][3]);
        sb.z = pk_bf16(S[2 * kk + 1][0], S[2 * kk + 1][1]); sb.w = pk_bf16(S[2 * kk + 1][2], S[2 * kk + 1][3]);
        o = mfma32(q[kk], __builtin_bit_cast(bf16x8, sb), o);
    }
    MFMA_FENCE();
    oout = o;
    if (orow != nullptr && (!sample || fq == fqm)) {
#pragma unroll
        for (int i = 0; i < 4; ++i) orow[(size_t)(4 * fq + i) * 512] = o[i];
    }
#pragma unroll
    for (int blk = 0; blk < 8; ++blk) {
        bf16x4 kt = kT[blk];
        if (sample && fq != fqm) kt = (bf16x4){0, 0, 0, 0};
        S[blk] = mfma16(kt, v, S[blk]);
    }
    MFMA_FENCE();
#pragma unroll
    for (int blk = 0; blk < 8; ++blk) S[blk] *= av[blk];
}
__device__ __forceinline__ void hgrn_sample_item(int l, int b, int h, int wave, int lane) {
    const int fr = lane & 15, fq = lane >> 4, cb = 128 * h, v0 = cb + 16 * wave;
    const bf16_t* qt = (const bf16_t*)(gws() + WS_QT); const bf16_t* kt = (const bf16_t*)(gws() + WS_KT);
    const bf16_t* ktT = (const bf16_t*)(gws() + WS_KTT); const bf16_t* vT = (const bf16_t*)(gws() + WS_VT);
    float* oraw = (float*)(gws() + WS_ORAW);
    const int R0 = MPROMPT + 4 * b, r0 = R0 & ~15, fqm = b & 3;
    f32x4 S[8];
    const float* s0 = gin(2) + (((size_t)l * 128 + b) * 4 + h) * 16384;
#pragma unroll
    for (int blk = 0; blk < 8; ++blk)
#pragma unroll
        for (int i = 0; i < 4; ++i) S[blk][i] = s0[(size_t)(16 * blk + 4 * fq + i) * 128 + 16 * wave + fr];
    bf16x8 q[4], k[4]; bf16x4 kT[8], v; f32x4 av[8];
    const size_t ro = (size_t)(r0 + fr) * 512 + cb + 4 * fq;
#pragma unroll
    for (int kk = 0; kk < 4; ++kk) {
        const u32x2 a0 = *(const u32x2*)(qt + ro + 32 * kk), a1 = *(const u32x2*)(qt + ro + 32 * kk + 16);
        const u32x2 b0 = *(const u32x2*)(kt + ro + 32 * kk), b1 = *(const u32x2*)(kt + ro + 32 * kk + 16);
        q[kk] = __builtin_bit_cast(bf16x8, ((u32x4){a0.x, a0.y, a1.x, a1.y})); k[kk] = __builtin_bit_cast(bf16x8, ((u32x4){b0.x, b0.y, b1.x, b1.y}));
    }
    const size_t to = (size_t)(r0 >> 4) * 512 * 16 + 4 * fq;
    const float* ap = (const float*)(gws() + WS_ADECS) + (size_t)b * 512 + cb + 4 * fq;
#pragma unroll
    for (int blk = 0; blk < 8; ++blk) { kT[blk] = *(const bf16x4*)(ktT + to + (size_t)(cb + 16 * blk + fr) * 16); av[blk] = *(const f32x4*)(ap + 16 * blk); }
    v = *(const bf16x4*)(vT + to + (size_t)(v0 + fr) * 16);
    f32x4 odummy;
    hgrn_core(q, k, kT, v, av, S, oraw + (size_t)r0 * 512 + v0 + fr, odummy, true, fqm, fr, fq);
    float* so = gout() + O_HGS + (((size_t)l * 128 + b) * 4 + h) * 16384;
#pragma unroll
    for (int blk = 0; blk < 8; ++blk)
#pragma unroll
        for (int i = 0; i < 4; ++i) so[(size_t)(16 * blk + 4 * fq + i) * 128 + 16 * wave + fr] = S[blk][i];
}
constexpr int HST = 16896, HNS = 7;
__device__ __forceinline__ void hgrn_issue(LAS unsigned char* lds, int ci, int row0, int cb, int wave, int lane) {
    const int cc = ci < 129 ? ci : 128, r0 = row0 + 16 * cc, chunk = r0 >> 4;
    LAS unsigned char* st = lds + (ci % HNS) * HST;
    const unsigned char* ws = gws();
    const int w4 = wave - 4, t = w4 * 64 + lane, row = t >> 4, c = (t & 15) ^ row;
    const size_t rowoff = ((size_t)(r0 + row) * 512 + cb + c * 8) * 2, toff = ((size_t)chunk * 512 + cb) * 32 + (size_t)t * 16;
    __builtin_amdgcn_global_load_lds((const unsigned*)(ws + WS_QT + rowoff), (LAS unsigned*)(st + w4 * 1024), 16, 0, 0);
    __builtin_amdgcn_global_load_lds((const unsigned*)(ws + WS_KT + rowoff), (LAS unsigned*)(st + 4096 + w4 * 1024), 16, 0, 0);
    __builtin_amdgcn_global_load_lds((const unsigned*)(ws + WS_KTT + toff), (LAS unsigned*)(st + 8192 + w4 * 1024), 16, 0, 0);
    __builtin_amdgcn_global_load_lds((const unsigned*)(ws + WS_VT + toff), (LAS unsigned*)(st + 12288 + w4 * 1024), 16, 0, 0);
    if (wave == 4 && lane < 32)
        __builtin_amdgcn_global_load_lds((const unsigned*)(ws + WS_ADEC + ((size_t)chunk * 512 + cb) * 4 + lane * 16), (LAS unsigned*)(st + 16384), 16, 0, 0);
}
__device__ __forceinline__ void hgrn_scores(LAS const unsigned char* st, LAS unsigned char* pb, int lane) {
    const int fr = lane & 15, fq = lane >> 4;
    f32x4 sc = (f32x4){0.f, 0.f, 0.f, 0.f};
#pragma unroll
    for (int kk = 0; kk < 4; ++kk) {
        const int e0 = 32 * kk + 4 * fq, e1 = e0 + 16;
        const int o0 = fr * 256 + (((e0 >> 3) ^ fr) << 4) + (e0 & 7) * 2, o1 = fr * 256 + (((e1 >> 3) ^ fr) << 4) + (e1 & 7) * 2;
        const u32x2 a0 = *(LAS const u32x2*)(st + o0), a1 = *(LAS const u32x2*)(st + o1);
        const u32x2 b0 = *(LAS const u32x2*)(st + 4096 + o0), b1 = *(LAS const u32x2*)(st + 4096 + o1);
        sc = mfma32(__builtin_bit_cast(bf16x8, ((u32x4){b0.x, b0.y, b1.x, b1.y})), __builtin_bit_cast(bf16x8, ((u32x4){a0.x, a0.y, a1.x, a1.y})), sc);
    }
    MFMA_FENCE();
#pragma unroll
    for (int i = 0; i < 4; ++i) sc[i] = ((4 * fq + i) <= fr) ? sc[i] : 0.f;
    u32x2 pw; pw.x = pk_bf16(sc[0], sc[1]); pw.y = pk_bf16(sc[2], sc[3]);
    *(LAS u32x2*)(pb + lane * 8) = pw;
}
__device__ __forceinline__ void hgrn_core_p(const bf16x8 (&q)[4], const bf16x4 P, const bf16x4 (&kT)[8], const bf16x4 v, const f32x4 (&av)[8], f32x4 (&S)[8], f32x4& oout) {
    f32x4 o = mfma16(P, v, (f32x4){0.f, 0.f, 0.f, 0.f});
#pragma unroll
    for (int kk = 0; kk < 4; ++kk) {
        u32x4 sb; sb.x = pk_bf16(S[2 * kk][0], S[2 * kk][1]); sb.y = pk_bf16(S[2 * kk][2], S[2 * kk][3]);
        sb.z = pk_bf16(S[2 * kk + 1][0], S[2 * kk + 1][1]); sb.w = pk_bf16(S[2 * kk + 1][2], S[2 * kk + 1][3]);
        o = mfma32(q[kk], __builtin_bit_cast(bf16x8, sb), o);
    }
#pragma unroll
    for (int blk = 0; blk < 8; ++blk) S[blk] = mfma16(kT[blk], v, S[blk]);
    MFMA_FENCE();
    oout = o;
#pragma unroll
    for (int blk = 0; blk < 8; ++blk) S[blk] *= av[blk];
}
__device__ __forceinline__ void hgrn_prompt_item(int l, int b, int h, int half, LAS unsigned char* lds, int tid, int wave, int lane) {
    const int fr = lane & 15, fq = lane >> 4, cb_ = 128 * h, vloc = 64 * half + 16 * (wave & 3), v0 = cb_ + vloc, row0 = b * LP;
    const bool comp = wave < 4;
    LAS unsigned char* pbuf = lds + HNS * HST;
    float* oraw = (float*)(gws() + WS_ORAW);
    f32x4 S[8];
#pragma unroll
    for (int blk = 0; blk < 8; ++blk) S[blk] = (f32x4){0.f, 0.f, 0.f, 0.f};
    if (!comp) {
        for (int ci = 0; ci < HNS - 1; ++ci) hgrn_issue(lds, ci, row0, cb_, wave, lane);
        if (wave == 4) asm volatile("s_waitcnt vmcnt(25)" ::: "memory"); else asm volatile("s_waitcnt vmcnt(20)" ::: "memory");
    }
    __builtin_amdgcn_s_barrier();
    asm volatile("" ::: "memory");
    if (wave == 5) { hgrn_scores(lds, pbuf, lane); LGKM0(); }
    f32x4 ob[4];
    for (int cb = 0; cb < 129; cb += 4) {
#pragma unroll
        for (int j = 0; j < 4; ++j) {
            const int ci = cb + j;
            if (ci < 129) {
                if (wave == 4) asm volatile("s_waitcnt vmcnt(20)" ::: "memory"); else if (wave > 4) asm volatile("s_waitcnt vmcnt(16)" ::: "memory");
                __builtin_amdgcn_s_barrier();
                asm volatile("" ::: "memory");
                if (comp) {
                    if (j == 0 && cb > 0) {
#pragma unroll
                        for (int jj = 0; jj < 4; ++jj)
#pragma unroll
                            for (int i = 0; i < 4; ++i) oraw[(size_t)(row0 + 16 * (cb - 4 + jj) + 4 * fq + i) * 512 + v0 + fr] = ob[jj][i];
                    }
                    LAS const unsigned char* st = lds + (ci % HNS) * HST;
                    bf16x8 q[4]; bf16x4 kT[8], v; f32x4 av[8];
#pragma unroll
                    for (int kk = 0; kk < 4; ++kk) {
                        const int e0 = 32 * kk + 4 * fq, e1 = e0 + 16;
                        const int o0 = fr * 256 + (((e0 >> 3) ^ fr) << 4) + (e0 & 7) * 2, o1 = fr * 256 + (((e1 >> 3) ^ fr) << 4) + (e1 & 7) * 2;
                        const u32x2 a0 = *(LAS const u32x2*)(st + o0), a1 = *(LAS const u32x2*)(st + o1);
                        q[kk] = __builtin_bit_cast(bf16x8, ((u32x4){a0.x, a0.y, a1.x, a1.y}));
                    }
#pragma unroll
                    for (int blk = 0; blk < 8; ++blk) {
                        kT[blk] = *(LAS const bf16x4*)(st + 8192 + (16 * blk + fr) * 32 + 8 * fq);
                        av[blk] = *(LAS const f32x4*)(st + 16384 + (16 * blk + 4 * fq) * 4);
                    }
                    v = *(LAS const bf16x4*)(st + 12288 + (vloc + fr) * 32 + 8 * fq);
                    const bf16x4 P = *(LAS const bf16x4*)(pbuf + (ci & 1) * 512 + lane * 8);
                    hgrn_core_p(q, P, kT, v, av, S, ob[j]);
                } else {
                    hgrn_issue(lds, ci + HNS - 1, row0, cb_, wave, lane);
                    if (wave == 5 && ci + 1 < 129) { hgrn_scores(lds + ((ci + 1) % HNS) * HST, pbuf + ((ci + 1) & 1) * 512, lane); LGKM0(); }
                }
            }
        }
    }
    if (comp) {
#pragma unroll
        for (int i = 0; i < 4; ++i) oraw[(size_t)(row0 + 16 * 128 + 4 * fq + i) * 512 + v0 + fr] = ob[0][i];
    }
    asm volatile("s_waitcnt vmcnt(0)" ::: "memory");
    __syncthreads();
    if (comp) {
        float* so = gout() + O_HGP + (((size_t)l * 8 + b) * 4 + h) * 16384;
#pragma unroll
        for (int blk = 0; blk < 8; ++blk)
#pragma unroll
            for (int i = 0; i < 4; ++i) so[(size_t)(16 * blk + 4 * fq + i) * 128 + vloc + fr] = S[blk][i];
    }
}

struct S5C { bf16x4 Bb[8]; bf16x8 Cf[4]; float ar, ai, dsk; };
__device__ __forceinline__ void s5_load_const(S5C& c, int l, int g, int lane) {
    const int fr = lane & 15, fq = lane >> 4, lg = l * 32 + g;
    const bf16_t* bbT = (const bf16_t*)(gws() + WS_BBT); const bf16_t* cT = (const bf16_t*)(gws() + WS_CT);
#pragma unroll
    for (int blk = 0; blk < 8; ++blk) c.Bb[blk] = *(const bf16x4*)(bbT + ((size_t)lg * 128 + 16 * blk + fr) * 16 + 4 * fq);
#pragma unroll
    for (int kk = 0; kk < 4; ++kk) c.Cf[kk] = *(const bf16x8*)(cT + ((size_t)lg * 16 + fr) * 128 + 32 * kk + 8 * fq);
    const f32x2 a = ((const f32x2*)(gws() + WS_ABAR))[lg * 64 + lane];
    c.ar = a.x; c.ai = a.y; c.dsk = gin(21)[lg * 16 + fr];
}
__device__ __forceinline__ bf16x4 s5_ua(const bf16_t* ub, int r0, int g, int fr, int fq) { return *(const bf16x4*)(ub + (size_t)(r0 + fr) * 512 + 16 * g + 4 * fq); }
__device__ __forceinline__ void s5_bu_v(const S5C& c, const bf16x4 ua, LAS float* bu, int fr, int fq);
__device__ __forceinline__ void s5_bu(const S5C& c, const bf16_t* ub, int r0, int g, LAS float* bu, int fr, int fq) { s5_bu_v(c, s5_ua(ub, r0, g, fr, fq), bu, fr, fq); }
__device__ __forceinline__ void s5_bu_v(const S5C& c, const bf16x4 ua, LAS float* bu, int fr, int fq) {
    f32x4 d[8];
#pragma unroll
    for (int blk = 0; blk < 8; ++blk) d[blk] = mfma16(ua, c.Bb[blk], (f32x4){0.f, 0.f, 0.f, 0.f});
    MFMA_FENCE();
#pragma unroll
    for (int blk = 0; blk < 8; ++blk)
#pragma unroll
        for (int i = 0; i < 4; ++i) bu[(4 * fq + i) * 132 + 16 * blk + fr] = d[blk][i];
}
__device__ __forceinline__ void s5_uu(unsigned (&uu)[4], const bf16_t* ub, int r0, int g, int fr, int fq) {
#pragma unroll
    for (int i = 0; i < 4; ++i) uu[i] = ub[(size_t)(r0 + 4 * fq + i) * 512 + 16 * g + fr];
}
__device__ __forceinline__ void s5_y(const S5C& c, const unsigned (&uu)[4], bf16_t* yg, int r0, int g, LAS const bf16_t* xs, int fr, int fq) {
    f32x4 y = (f32x4){0.f, 0.f, 0.f, 0.f};
#pragma unroll
    for (int kk = 0; kk < 4; ++kk) { const bf16x8 a = *(LAS const bf16x8*)(xs + fr * 136 + 32 * kk + 8 * fq); y = mfma32(a, c.Cf[kk], y); }
    MFMA_FENCE();
#pragma unroll
    for (int i = 0; i < 4; ++i) {
        const size_t o = (size_t)(r0 + 4 * fq + i) * 512 + 16 * g + fr;
        const float uf = __uint_as_float(uu[i] << 16);
        yg[o] = to_bf16(gelu_tanh(y[i] + c.dsk * uf));
    }
}
__device__ __forceinline__ void s5_prompt_item(int l, int b, int g, LAS unsigned char* lds, int wave, int lane) {
    const int fr = lane & 15, fq = lane >> 4;
    LAS float* bu = (LAS float*)(lds + wave * 12800); LAS bf16_t* xs = (LAS bf16_t*)(lds + wave * 12800 + 8448);
    LAS float* carr = (LAS float*)(lds + 8 * 12800);
    const bf16_t* ub = (const bf16_t*)(gws() + WS_UB); bf16_t* yg = (bf16_t*)(gws() + WS_YG);
    S5C c; s5_load_const(c, l, g, lane);
    const int c0 = 16 * wave, c1 = (wave == 7) ? 129 : 16 * wave + 16, row0 = b * LP;
#ifdef DIAG_NO_S5
    for (int ci = c0; ci < c1; ++ci) for (int i = 0; i < 4; ++i) yg[(size_t)(row0 + 16 * ci + 4 * fq + i) * 512 + 16 * g + fr] = 0;
    if (wave == 7) { const size_t o = (((size_t)l * 8 + b) * 32 + g) * 64 + lane; gout()[O_S5RP + o] = 0.f; gout()[O_S5IP + o] = 0.f; }
    return;
#endif
    float xr = 0.f, xi = 0.f;
    if (wave < 7) {
        bf16x4 ua_n = s5_ua(ub, row0 + 16 * c0, g, fr, fq);
        for (int ci = c0; ci < c1; ++ci) {
            const bf16x4 ua = ua_n;
            ua_n = s5_ua(ub, row0 + 16 * (ci + 1 < c1 ? ci + 1 : ci), g, fr, fq);
            s5_bu_v(c, ua, bu, fr, fq);
            LGKM0();
            f32x2 bv[16];
#pragma unroll
            for (int t = 0; t < 16; ++t) bv[t] = *(LAS const f32x2*)(bu + t * 132 + 2 * lane);
#pragma unroll
            for (int t = 0; t < 16; ++t) { const float nr = c.ar * xr - c.ai * xi + bv[t].x, ni = c.ar * xi + c.ai * xr + bv[t].y; xr = nr; xi = ni; }
            LGKM0();
        }
    }
    carr[(wave * 64 + lane) * 2] = xr; carr[(wave * 64 + lane) * 2 + 1] = xi;
    __syncthreads();
    float pr = c.ar, pi = c.ai;
#pragma unroll
    for (int s = 0; s < 8; ++s) { const float nr = pr * pr - pi * pi, ni = 2.f * pr * pi; pr = nr; pi = ni; }
    xr = 0.f; xi = 0.f;
    for (int w = 0; w < wave; ++w) {
        const float lr = carr[(w * 64 + lane) * 2], li = carr[(w * 64 + lane) * 2 + 1];
        const float nr = pr * xr - pi * xi + lr, ni = pr * xi + pi * xr + li; xr = nr; xi = ni;
    }
    bf16x4 ua_n = s5_ua(ub, row0 + 16 * c0, g, fr, fq); unsigned uu_n[4]; s5_uu(uu_n, ub, row0 + 16 * c0, g, fr, fq);
    for (int ci = c0; ci < c1; ++ci) {
        const int r0 = row0 + 16 * ci, rn = row0 + 16 * (ci + 1 < c1 ? ci + 1 : ci);
        const bf16x4 ua = ua_n; unsigned uu[4];
#pragma unroll
        for (int i = 0; i < 4; ++i) uu[i] = uu_n[i];
        ua_n = s5_ua(ub, rn, g, fr, fq); s5_uu(uu_n, ub, rn, g, fr, fq);
        s5_bu_v(c, ua, bu, fr, fq);
        LGKM0();
        f32x2 bv[16]; unsigned xp[16];
#pragma unroll
        for (int t = 0; t < 16; ++t) bv[t] = *(LAS const f32x2*)(bu + t * 132 + 2 * lane);
#pragma unroll
        for (int t = 0; t < 16; ++t) { const float nr = c.ar * xr - c.ai * xi + bv[t].x, ni = c.ar * xi + c.ai * xr + bv[t].y; xr = nr; xi = ni; xp[t] = pk_bf16(xr, xi); }
#pragma unroll
        for (int t = 0; t < 16; ++t) *(LAS unsigned*)(xs + t * 136 + 2 * lane) = xp[t];
        LGKM0();
        s5_y(c, uu, yg, r0, g, xs, fr, fq);
        LGKM0();
    }
    if (wave == 7) {
        const size_t o = (((size_t)l * 8 + b) * 32 + g) * 64 + lane;
        gout()[O_S5RP + o] = xr; gout()[O_S5IP + o] = xi;
    }
    __syncthreads();
}
__device__ __forceinline__ void s5_sample_wave(int l, int bblk, int g, LAS unsigned char* lds, int wave, int lane) {
    const int fr = lane & 15, fq = lane >> 4;
    LAS float* bu = (LAS float*)(lds + wave * 12800); LAS bf16_t* xs = (LAS bf16_t*)(lds + wave * 12800 + 8448);
    const bf16_t* ub = (const bf16_t*)(gws() + WS_UB); bf16_t* yg = (bf16_t*)(gws() + WS_YG);
    S5C c; s5_load_const(c, l, g, lane);
    const int r0 = MPROMPT + 16 * bblk;
#ifdef DIAG_NO_S5
    for (int i = 0; i < 4; ++i) yg[(size_t)(r0 + 4 * fq + i) * 512 + 16 * g + fr] = 0;
    for (int s = 0; s < 4; ++s) { const size_t o = (((size_t)l * 128 + 4 * bblk + s) * 32 + g) * 64 + lane; gout()[O_S5RS + o] = 0.f; gout()[O_S5IS + o] = 0.f; }
    return;
#endif
    unsigned uu[4]; s5_uu(uu, ub, r0, g, fr, fq);
    s5_bu(c, ub, r0, g, bu, fr, fq);
    LGKM0();
#pragma unroll
    for (int s = 0; s < 4; ++s) {
        const int b = 4 * bblk + s;
        const size_t o = (((size_t)l * 128 + b) * 32 + g) * 64 + lane;
        float xr = gin(3)[o], xi = gin(4)[o];
#pragma unroll
        for (int tt = 0; tt < 4; ++tt) {
            const int t = 4 * s + tt;
            const f32x2 bv = *(LAS const f32x2*)(bu + t * 132 + 2 * lane);
            const float nr = c.ar * xr - c.ai * xi + bv.x, ni = c.ar * xi + c.ai * xr + bv.y; xr = nr; xi = ni;
            *(LAS unsigned*)(xs + t * 136 + 2 * lane) = pk_bf16(xr, xi);
        }
        gout()[O_S5RS + o] = xr; gout()[O_S5IS + o] = xi;
    }
    LGKM0();
    s5_y(c, uu, yg, r0, g, xs, fr, fq);
    LGKM0();
}

#define BW_XCNT(x) (32 * (x))
#define BW_XSUB(x) (32 * (16 + (x)))
#define BW_XGEN(x) (32 * (32 + (x)))
#define BW_TOP (32 * 48)
#define BW_TOPGEN (32 * 49)
__device__ __forceinline__ unsigned bw_ld(unsigned* p) { return __hip_atomic_load(p, __ATOMIC_RELAXED, __HIP_MEMORY_SCOPE_AGENT); }
__device__ __forceinline__ unsigned bw_add(unsigned* p, unsigned v) { return __hip_atomic_fetch_add(p, v, __ATOMIC_RELAXED, __HIP_MEMORY_SCOPE_AGENT); }
__device__ __forceinline__ unsigned xcc_id() { return (unsigned)__builtin_amdgcn_s_getreg((3 << 11) | 20) & 0xFu; }
#define BW_SPIN(cond) do { unsigned _sp = 0; while (cond) { __builtin_amdgcn_s_sleep(1); if (++_sp > (1u << 22)) break; } } while (0)
__device__ __forceinline__ void fast_grid_barrier(unsigned* bar, unsigned k, unsigned x, unsigned nloc, unsigned nx, int tidnow) {
    asm volatile("s_waitcnt vmcnt(0) lgkmcnt(0)" ::: "memory");
    __syncthreads();
    if (tidnow == 0) {
        const unsigned old = bw_add(&bar[BW_XSUB(x)], 1u);
        if (old + 1u == k * nloc) {
            __builtin_amdgcn_fence(__ATOMIC_RELEASE, "agent");
            asm volatile("s_waitcnt vmcnt(0)" ::: "memory");
            const unsigned og = bw_add(&bar[BW_TOP], 1u);
            if (og + 1u == k * nx) bw_add(&bar[BW_TOPGEN], 1u);
            else BW_SPIN(bw_ld(&bar[BW_TOPGEN]) < k);
            __builtin_amdgcn_fence(__ATOMIC_ACQUIRE, "agent");
            bw_add(&bar[BW_XGEN(x)], 1u);
            asm volatile("s_waitcnt vmcnt(0)" ::: "memory");
        } else {
            BW_SPIN(bw_ld(&bar[BW_XGEN(x)]) < k);
            __builtin_amdgcn_fence(__ATOMIC_ACQUIRE, "agent");
            asm volatile("s_waitcnt vmcnt(0)" ::: "memory");
        }
    }
    __syncthreads();
}
__device__ __forceinline__ void finish_remainder(unsigned char* ws, int ssni, int ss5i, int bid, int G, int wave, int lane) {
    pg8::Order S; S.init(MPAD / 256, D / 256, G, bid, 1, 512);
    float* h32 = (float*)(ws + WS_H32); bf16_t* hbw = (bf16_t*)(ws + WS_HB);
    float* ssn = (float*)(ws + WS_SS) + (size_t)ssni * MPAD * 16;
    const int nrem = S.nwg - G;
    for (int task = bid * 8 + wave; task < nrem * 256; task += G * 8) {
        int pm, pn; S.tile_of(G + (task >> 8), pm, pn);
        const int row = pm * 256 + (task & 255), c = pn * 256 + lane * 4;
        f32x4 v = *(const f32x4*)(h32 + (size_t)row * D + c);
        const float* pb = (const float*)(ws + WS_PART) + (size_t)(task >> 8) * 4 * 65536 + (size_t)(task & 255) * 256 + lane * 4;
        const f32x4 p0 = *(const f32x4*)(pb), p1 = *(const f32x4*)(pb + 65536), p2 = *(const f32x4*)(pb + 2 * 65536), p3 = *(const f32x4*)(pb + 3 * 65536);
        float sc = 1.f;
        if (ss5i >= 0) sc = rsqrtf(row_ss8((const float*)(ws + WS_SS) + (size_t)ss5i * MPAD * 16, row) * (1.f / 512.f) + EPS);
        v += (p0 + p1) + (p2 + p3) * sc;
        *(f32x4*)(h32 + (size_t)row * D + c) = v;
        u32x2 w; w.x = pk_bf16(v[0], v[1]); w.y = pk_bf16(v[2], v[3]);
        *(u32x2*)(hbw + (size_t)row * D + c) = w;
        float sq = v[0] * v[0] + v[1] * v[1] + v[2] * v[2] + v[3] * v[3];
#pragma unroll
        for (int o = 32; o > 0; o >>= 1) sq += __shfl_xor(sq, o);
        if (lane < 4) ssn[(size_t)row * 16 + pn * 4 + lane] = (lane == 0) ? sq : 0.f;
    }
}
#define GRID_SYNC() do { asm volatile("s_waitcnt vmcnt(0) lgkmcnt(0)" ::: "memory"); grid.sync(); if (wave0 == 0) asm volatile("buffer_inv sc1\n\ts_waitcnt vmcnt(0)" ::: "memory"); __syncthreads(); } while (0)
__global__ void __launch_bounds__(NTHREADS, 2) fwd_megakernel(Params p) {
    extern __shared__ __attribute__((aligned(16))) unsigned char lds_raw[];
    LAS unsigned char* lds = (LAS unsigned char*)lds_raw;
    cg::grid_group grid = cg::this_grid();
    const int bid0 = blockIdx.x, G0 = gridDim.x;
    const int wave0 = __builtin_amdgcn_readfirstlane(threadIdx.x >> 6);
#define TID_NOW() ({ unsigned _m = ~0u; asm volatile("" : "+s"(_m)); wave0 * 64 + (int)__builtin_amdgcn_mbcnt_hi(_m, __builtin_amdgcn_mbcnt_lo(_m, 0u)); })

    const unsigned myx = xcc_id();
    if (threadIdx.x == 0) bw_add((unsigned*)(gws() + WS_BAR) + BW_XCNT(myx), 1u);
    p0_init(lds, G0, bid0, TID_NOW());
    GRID_SYNC();
    unsigned nloc = 0u, nx = 0u;
    { unsigned* bar = (unsigned*)(gws() + WS_BAR);
      for (unsigned j = 0; j < 16; ++j) { const unsigned c = bw_ld(&bar[BW_XCNT(j)]); nx += (c > 0u) ? 1u : 0u; nloc = (j == myx) ? c : nloc; }
      nloc = __builtin_amdgcn_readfirstlane(nloc); nx = __builtin_amdgcn_readfirstlane(nx); }

    unsigned kb = 0u;
    constexpr int NSLOT = (DUP_SLOT >= 0) ? 9 : 8;
    for (int step = 0; step < DEPTH * NSLOT; ++step) {
        const int l = step / NSLOT, s9 = step - l * NSLOT, s = (DUP_SLOT >= 0 && s9 > DUP_SLOT) ? s9 - 1 : s9;
        int bid = bid0, G = G0; asm volatile("" : "+s"(bid), "+s"(G));
        unsigned char* ws = launder(gws());
        const bf16_t* hb = (const bf16_t*)(ws + WS_HB); const bf16_t* act = (const bf16_t*)(ws + WS_ACT);
        int tid = TID_NOW(); asm volatile("" : "+v"(tid));
        const int wave = wave0, lane = tid & 63;
        unsigned char* wl = ws + WS_W + (size_t)l * WL_SZ;
        int fin_ssn = -1, fin_ss5 = -1;
        if (EN(0) && (s == 0 || s == 6)) {
            pg8::Gemm g{hb, (const bf16_t*)(wl + (s == 0 ? WL_A1 : WL_A2)), D, D, D};
            pg8::Order S; S.init(MPAD / 256, FFN2 / 256, G, bid, 1, D, KREP_UP);
            EpiSwiglu E{ws, 3 * l + (s == 0 ? 0 : 2)};
            pg8::gemm_phase(lds, g, S, E, tid);
        } else if (EN(1) && (s == 1 || s == 7)) {
            pg8::Gemm g{act, (const bf16_t*)(wl + (s == 1 ? WL_D1 : WL_D2)), FFN, FFN, FFN};
            pg8::Order S; S.init(MPAD / 256, D / 256, G, bid, 1, FFN, 1, (G == 256) ? DOWN_SPLIT : 0);
            EpiRes E{ws, 3 * l + (s == 1 ? 1 : 3), -1, 0.5f};
            pg8::gemm_phase(lds, g, S, E, tid);
            if (S.nsplit > 0) { fin_ssn = 3 * l + (s == 1 ? 1 : 3); fin_ss5 = -1; }
        } else if (EN(2) && s == 2) {
            pg8::Gemm g{hb, (const bf16_t*)(wl + WL_IN), D, D, D};
            pg8::Order S; S.init(MPAD / 256, INC / 256, G, bid, 1, D);
            EpiWin E{ws, l};
            pg8::gemm_phase(lds, g, S, E, tid);
        } else if (EN(3) && s == 3) {
            {
                if (bid < 64) hgrn_prompt_item(l, bid >> 3, (bid >> 1) & 3, bid & 1, lds, tid, wave, lane);
                else { for (int it = bid - 64; it < 256; it += G - 64) s5_prompt_item(l, it >> 5, it & 31, lds, wave, lane); }
                if (bid >= 64) {
                    for (int it = bid - 64; it < 640; it += G - 64) {
                        if (it < 512) hgrn_sample_item(l, it >> 2, it & 3, wave, lane);
                        else { const int wi = (it - 512) * 8 + wave; s5_sample_wave(l, wi >> 5, wi & 31, lds, wave, lane); }
                    }
                }
            }
        } else if (EN(4) && s == 4) {
            {
                pg8::Gemm g{(const bf16_t*)(ws + WS_YG), (const bf16_t*)(wl + WL_GLU), 512, 512, 512};
                pg8::Order S; S.init(MPAD / 256, 2, G, bid, 1, 512);
                EpiGlu E{ws, l};
                pg8::gemm_phase(lds, g, S, E, tid);
            }
            const float* oraw = (const float*)(ws + WS_ORAW); const bf16_t* gs = (const bf16_t*)(ws + WS_GS); bf16_t* mixin = (bf16_t*)(ws + WS_MIXIN);
            for (int row = bid * 8 + wave; row < M; row += G * 8) {
                const int c = lane * 8;
                const f32x4 a = *(const f32x4*)(oraw + (size_t)row * 512 + c), b = *(const f32x4*)(oraw + (size_t)row * 512 + c + 4);
                float sq = a[0] * a[0] + a[1] * a[1] + a[2] * a[2] + a[3] * a[3] + b[0] * b[0] + b[1] * b[1] + b[2] * b[2] + b[3] * b[3];
                sq += __shfl_xor(sq, 1); sq += __shfl_xor(sq, 2); sq += __shfl_xor(sq, 4); sq += __shfl_xor(sq, 8);
                const float r = rsqrtf(sq * (1.f / 128.f) + EPS);
                const u32x4 gw = *(const u32x4*)(gs + (size_t)row * 512 + c);
                u32x4 w;
                w.x = pk_bf16(a[0] * r * bf16_lo(gw.x), a[1] * r * bf16_hi(gw.x)); w.y = pk_bf16(a[2] * r * bf16_lo(gw.y), a[3] * r * bf16_hi(gw.y));
                w.z = pk_bf16(b[0] * r * bf16_lo(gw.z), b[1] * r * bf16_hi(gw.z)); w.w = pk_bf16(b[2] * r * bf16_lo(gw.w), b[3] * r * bf16_hi(gw.w));
                *(u32x4*)(mixin + (size_t)row * 1024 + c) = w;
            }
        } else if (EN(5) && s == 5) {
            pg8::Gemm g{(const bf16_t*)(ws + WS_MIXIN), (const bf16_t*)(wl + WL_OUT), D, D, 512};
            pg8::Order S; S.init(MPAD / 256, D / 256, G, bid, 2, 512, 1, (G == 256) ? DOWN_SPLIT : 0);
            EpiRes E{ws, 3 * l + 2, 13 + l, 1.0f};
            pg8::gemm_phase(lds, g, S, E, tid);
            if (S.nsplit > 0) { fin_ssn = 3 * l + 2; fin_ss5 = 13 + l; }
        }
        if (fin_ssn >= 0) { fast_grid_barrier((unsigned*)(ws + WS_BAR), ++kb, myx, nloc, nx, tid); finish_remainder(ws, fin_ssn, fin_ss5, bid, G, wave, lane); }
        fast_grid_barrier((unsigned*)(ws + WS_BAR), ++kb, myx, nloc, nx, tid);
    }
    {
        int tidf = TID_NOW(); asm volatile("" : "+v"(tidf));
        const int bid = bid0, G = G0; unsigned char* ws = launder(gws());
        const int wave = wave0, lane = tidf & 63;
        const float* ssf = (const float*)(ws + WS_SS) + (size_t)12 * MPAD * 16; const float* nf = gin(30); const float* h32 = (const float*)(ws + WS_H32);
        for (int row = bid * 8 + wave; row < M; row += G * 8) {
            float* dst;
            if (row < MPROMPT) { const int b = row / LP, pos = row - b * LP; if (pos < 16) continue; dst = gout() + O_YP + ((size_t)b * SEQ + pos - 16) * D; }
            else dst = gout() + O_YS + (size_t)(row - MPROMPT) * D;
            const float rs = rsqrtf(row_ss16(ssf, row) * (1.f / 1024.f) + EPS);
#pragma unroll
            for (int i = 0; i < 4; ++i) {
                const int c = (i * 64 + lane) * 4;
                const f32x4 v = *(const f32x4*)(h32 + (size_t)row * D + c), gn = *(const f32x4*)(nf + c);
                *(f32x4*)(dst + c) = v * rs * gn;
            }
        }
    }
}

extern "C" void kernel_launch(void* const* d_in, const int* in_sizes, int n_in, void* d_out, int out_size, void* d_ws, size_t ws_size, hipStream_t stream) {
    static int grid_blocks = 0;
    if (grid_blocks == 0) {
        int dev = 0, cus = 0, per_cu = 0;
        hipGetDevice(&dev);
        hipDeviceGetAttribute(&cus, hipDeviceAttributeMultiprocessorCount, dev);
        hipFuncSetAttribute((const void*)fwd_megakernel, hipFuncAttributeMaxDynamicSharedMemorySize, LDS_BYTES);
        hipOccupancyMaxActiveBlocksPerMultiprocessor(&per_cu, (const void*)fwd_megakernel, NTHREADS, LDS_BYTES);
        if (per_cu < 1) per_cu = 1;
        grid_blocks = cus;
        if (ws_size < WS_END) { fprintf(stderr, "kernel_launch: workspace too small: %zu < %zu\n", ws_size, (size_t)WS_END); grid_blocks = -1; }
        if (n_in != 31) fprintf(stderr, "kernel_launch: expected 31 inputs, got %d\n", n_in);
    }
    if (grid_blocks < 0) return;
    Params p{};
    for (int i = 0; i < 31; ++i) p.in[i] = (const float*)d_in[i];
    p.out = (float*)d_out; p.ws = (unsigned char*)d_ws;
    hipMemsetAsync((char*)d_ws + WS_BAR, 0, 8192, stream);
    void* args[] = {&p};
    hipError_t e = hipLaunchCooperativeKernel((const void*)fwd_megakernel, dim3(grid_blocks), dim3(NTHREADS), args, LDS_BYTES, stream);
    if (e != hipSuccess) fprintf(stderr, "cooperative launch failed: %s (grid %d)\n", hipGetErrorString(e), grid_blocks);
}
```

```cpp
#include <hip/hip_runtime.h>
#include <hip/hip_cooperative_groups.h>
#include <cstdio>
namespace cg = cooperative_groups;

#define LAS __attribute__((address_space(3)))
typedef unsigned short bf16_t;
typedef short bf16x8 __attribute__((ext_vector_type(8)));
typedef short bf16x4 __attribute__((ext_vector_type(4)));
typedef float f32x4 __attribute__((ext_vector_type(4)));
typedef float f32x2 __attribute__((ext_vector_type(2)));
typedef unsigned u32x4 __attribute__((ext_vector_type(4)));
typedef unsigned u32x2 __attribute__((ext_vector_type(2)));

constexpr int D = 1024, NB = 8, SEQ = 2048, LP = 2064, MPROMPT = NB * LP, M = 17024, MPAD = 17152;
constexpr int DEPTH = 4, FFN = 2816, FFN2 = 5632, INC = 2560;
constexpr float EPS = 1e-6f;
constexpr int NTHREADS = 512;
constexpr int LDS_BYTES = 131072;
#ifndef EN_MASK
#define EN_MASK 0x3F
#endif
#define EN(k) ((EN_MASK >> (k)) & 1)
#ifndef DOWN_SPLIT
#define DOWN_SPLIT 4
#endif
#ifndef KREP_UP
#define KREP_UP 1
#endif
#ifndef DUP_SLOT
#define DUP_SLOT -1
#endif

constexpr size_t O_YP = 0, O_YS = 16777216, O_HGP = O_YS + 524288, O_S5RP = O_HGP + 2097152, O_S5IP = O_S5RP + 65536,
                 O_HGS = O_S5IP + 65536, O_S5RS = O_HGS + 33554432, O_S5IS = O_S5RS + 1048576;

constexpr size_t SZ_WA = (size_t)FFN2 * D * 2, SZ_WD = (size_t)D * FFN * 2, SZ_WIN = (size_t)INC * D * 2, SZ_WGLU = 512 * 512 * 2, SZ_WOUT = (size_t)D * D * 2;
constexpr size_t WL_A1 = 0, WL_D1 = WL_A1 + SZ_WA, WL_A2 = WL_D1 + SZ_WD, WL_D2 = WL_A2 + SZ_WA, WL_IN = WL_D2 + SZ_WD, WL_GLU = WL_IN + SZ_WIN,
                 WL_OUT = WL_GLU + SZ_WGLU, WL_SZ = WL_OUT + SZ_WOUT;
constexpr size_t WS_W = 0;
constexpr size_t WS_H32 = WS_W + 4 * WL_SZ;
constexpr size_t WS_HB = WS_H32 + (size_t)MPAD * D * 4;
constexpr size_t WS_SS = WS_HB + (size_t)MPAD * D * 2;
constexpr size_t WS_LB = WS_SS + (size_t)17 * MPAD * 16 * 4;
constexpr size_t WS_ABAR = WS_LB + 8192;
constexpr size_t WS_BBT = WS_ABAR + 65536;
constexpr size_t WS_CT = WS_BBT + 524288;
constexpr size_t WS_MIX = WS_CT + 524288;
constexpr size_t R512 = (size_t)MPAD * 512 * 2;
constexpr size_t WS_QT = WS_MIX, WS_KT = WS_QT + R512, WS_KTT = WS_KT + R512, WS_VT = WS_KTT + R512, WS_GS = WS_VT + R512, WS_UB = WS_GS + R512,
                 WS_YG = WS_UB + R512, WS_ORAW = WS_YG + R512, WS_MIXIN = WS_ORAW + 2 * R512, WS_ADEC = WS_MIXIN + 2 * R512,
                 WS_ADECS = WS_ADEC + (size_t)(MPAD / 16) * 512 * 4, WS_BAR = WS_ADECS + 128 * 512 * 4, WS_PART = WS_BAR + 8192, WS_END = WS_PART + (size_t)12 * 4 * 256 * 256 * 4;
constexpr size_t WS_ACT = WS_MIX;
static_assert((size_t)MPAD * FFN * 2 <= WS_BAR - WS_MIX, "act alias");

struct Params { const float* in[31]; float* out; unsigned char* ws; };
typedef const __attribute__((address_space(4))) Params* KP;
__device__ __forceinline__ KP kargs() { KP q = (KP)__builtin_amdgcn_kernarg_segment_ptr(); asm volatile("" : "+s"(q)); return q; }
#define GAS __attribute__((address_space(1)))
template <class T> __device__ __forceinline__ T* as_global(T* q) { return (T*)(GAS T*)q; }
__device__ __forceinline__ unsigned char* launder(unsigned char* q) { GAS unsigned char* g = (GAS unsigned char*)q; asm volatile("" : "+s"(g)); return (unsigned char*)g; }
__device__ __forceinline__ const float* gin(int i) { return as_global(kargs()->in[i]); }
__device__ __forceinline__ float* gout() { return as_global(kargs()->out); }
__device__ __forceinline__ unsigned char* gws() { return as_global(kargs()->ws); }

typedef __bf16 bf16v2 __attribute__((ext_vector_type(2)));
__device__ __forceinline__ unsigned pk_bf16(float lo, float hi) { f32x2 v = {lo, hi}; bf16v2 b = __builtin_convertvector(v, bf16v2); return __builtin_bit_cast(unsigned, b); }
__device__ __forceinline__ bf16_t to_bf16(float x) { return (bf16_t)(pk_bf16(x, 0.f) & 0xffffu); }
__device__ __forceinline__ float bf16_lo(unsigned w) { return __uint_as_float(w << 16); }
__device__ __forceinline__ float bf16_hi(unsigned w) { return __uint_as_float(w & 0xffff0000u); }
__device__ __forceinline__ float frcp(float x) { return __builtin_amdgcn_rcpf(x); }
__device__ __forceinline__ float sigm(float x) { return frcp(1.f + __expf(-x)); }
__device__ __forceinline__ float silu(float x) { return x * sigm(x); }
__device__ __forceinline__ float gelu_tanh(float x) { return x * sigm(1.5957691216057308f * (x + 0.044715f * x * x * x)); }
template <int N> __device__ __forceinline__ float dpp_shr(float x) { return __int_as_float(__builtin_amdgcn_update_dpp(0, __float_as_int(x), 0x110 + N, 0xF, 0xF, true)); }
__device__ __forceinline__ float scan16(float x, bool sample, int fr) {
    float t = dpp_shr<1>(x); if (sample && (fr & 3) < 1) t = 0.f; x += t;
    t = dpp_shr<2>(x); if (sample && (fr & 3) < 2) t = 0.f; x += t;
    if (!sample) { x += dpp_shr<4>(x); x += dpp_shr<8>(x); }
    return x;
}
template <int N> __device__ __forceinline__ float dpp_shr1(float x) { return __int_as_float(__builtin_amdgcn_update_dpp(0x3f800000, __float_as_int(x), 0x110 + N, 0xF, 0xF, false)); }
__device__ __forceinline__ float cumprod16(float x, bool sample, int fr) {
    float t = dpp_shr1<1>(x); if (sample && (fr & 3) < 1) t = 1.f; x *= t;
    t = dpp_shr1<2>(x); if (sample && (fr & 3) < 2) t = 1.f; x *= t;
    if (!sample) { x *= dpp_shr1<4>(x); x *= dpp_shr1<8>(x); }
    return x;
}
__device__ __forceinline__ f32x4 mfma32(bf16x8 a, bf16x8 b, f32x4 c) { return __builtin_amdgcn_mfma_f32_16x16x32_bf16(a, b, c, 0, 0, 0); }
__device__ __forceinline__ f32x4 mfma16(bf16x4 a, bf16x4 b, f32x4 c) {
    const bf16x8 a8 = (bf16x8){a[0], a[1], a[2], a[3], 0, 0, 0, 0}, b8 = (bf16x8){b[0], b[1], b[2], b[3], 0, 0, 0, 0};
    return __builtin_amdgcn_mfma_f32_16x16x32_bf16(a8, b8, c, 0, 0, 0);
}
__device__ __forceinline__ float row_ss16(const float* base, int row) {
    const f32x4* q = (const f32x4*)(base + (size_t)row * 16);
    const f32x4 a = q[0], b = q[1], c = q[2], d = q[3];
    return ((a[0] + a[1]) + (a[2] + a[3])) + ((b[0] + b[1]) + (b[2] + b[3])) + ((c[0] + c[1]) + (c[2] + c[3])) + ((d[0] + d[1]) + (d[2] + d[3]));
}
__device__ __forceinline__ float row_ss8(const float* base, int row) {
    const f32x4* q = (const f32x4*)(base + (size_t)row * 16);
    const f32x4 a = q[0], b = q[1];
    return ((a[0] + a[1]) + (a[2] + a[3])) + ((b[0] + b[1]) + (b[2] + b[3]));
}
#define MFMA_FENCE() do { __builtin_amdgcn_sched_barrier(0); asm volatile("s_nop 15\n\ts_nop 15" ::: "memory"); __builtin_amdgcn_sched_barrier(0); } while (0)
#define LGKM0() asm volatile("s_waitcnt lgkmcnt(0)" ::: "memory")

namespace pg8 {
constexpr int BM = 256, BK = 64, HALF = 128, HTB = HALF * BK * 2, STAGE_BYTES = 8 * HTB, NXCD = 8, WGM = 4;
__device__ __forceinline__ int lds_byte(int r, int c) { const int st = (r >> 4) * 2 + (c >> 5), rr = r & 15, cc = c & 31, ob = rr * 64 + cc * 2; return st * 1024 + (ob ^ (((ob >> 9) & 1) << 5)); }
__device__ __forceinline__ void stage_rc(int b, int& R, int& C) { const int st = b / 1024, sb = b % 1024, swz = sb ^ (((sb >> 9) & 1) << 5); R = (st >> 1) * 16 + swz / 64; C = (st & 1) * 32 + (swz % 64) / 2; }

struct Unit { int pm, pn, kh, skip, k0, nt, part; };
struct Gemm { const bf16_t* A; const bf16_t* Bt; int lda, ldb, K; };
struct Order {
    int nM, nN, nwg, G, c, ks, rep, K, nsplit;
    __device__ void init(int nM_, int nN_, int G_, int c_, int ks_, int K_, int rep_ = 1, int nsplit_ = 0) { nM = nM_; nN = nN_; nwg = nM * nN; G = G_; c = c_; ks = ks_; rep = rep_; K = K_; nsplit = nsplit_; }
    __device__ void tile_of(int L, int& pm, int& pn) const {
        int wgid = L; { const int q = nwg / NXCD, r = nwg % NXCD, xcd = wgid % NXCD, off = wgid / NXCD; wgid = (xcd < r ? xcd * (q + 1) : r * (q + 1) + (xcd - r) * q) + off; }
        const int nig = WGM * nN, gid = wgid / nig, fm = gid * WGM, gsz = (nM - fm) < WGM ? (nM - fm) : WGM;
        pm = fm + ((wgid % nig) % gsz); pn = (wgid % nig) / gsz;
    }
    __device__ bool next(int i0, Unit& u) const {
        const int i = i0 / rep; u.skip = (i0 - i * rep) != rep - 1;
        if (nsplit > 0 && i >= ks) {
            if (i > ks) return false;
            const int L = G + c / nsplit; if (L >= nwg) return false;
            const int part = c - (c / nsplit) * nsplit, ntall = ks * K / BK;
            const int base = (ntall / nsplit) & ~1, extra = (ntall - base * nsplit) / 2;
            u.part = part; u.kh = c / nsplit; u.nt = base + (part < extra ? 2 : 0);
            u.k0 = (part * base + 2 * (part < extra ? part : extra)) * BK;
            tile_of(L, u.pm, u.pn); return true;
        }
        const int t = i / ks; u.kh = i - t * ks; u.part = -1; u.k0 = u.kh * K; u.nt = K / BK;
        const long L = (long)t * G + c; if (L >= nwg) return false;
        tile_of((int)L, u.pm, u.pn); return true;
    }
};

template <class Epi>
__device__ __forceinline__ void gemm_phase(LAS unsigned char* lds, const Gemm g, const Order& S, const Epi& E, int tid) {
    asm volatile("" : "+v"(tid));
    const int wid = __builtin_amdgcn_readfirstlane(tid >> 6), lane = tid & 63, wr = wid >> 2, wc = wid & 3, fr = lane & 15, fq = lane >> 4;
    unsigned voffA[2], voffB[2];
#pragma unroll
    for (int i = 0; i < 2; ++i) { int R, C; stage_rc(tid * 16 + i * 8192, R, C); voffA[i] = (unsigned)(R * g.lda + C) * 2u; voffB[i] = (unsigned)(R * g.ldb + C) * 2u; }
    const size_t kstep = (size_t)(BK * 2);
    const size_t hstepA = (size_t)HALF * g.lda * 2, hstepB = (size_t)HALF * g.ldb * 2;
    const size_t tstepA = 2 * hstepA, tstepB = 2 * hstepB;
    const unsigned ldsw = (unsigned)wid * 1024u;
    const int aoff = lds_byte(wr * 64 + fr, fq * 8), boff = lds_byte(wc * 32 + fr, fq * 8);
#define PG8_SA(b, h) (((b) * 2 + (h)) * HTB)
#define PG8_SB(b, h) ((4 + (b) * 2 + (h)) * HTB)
#define PG8_STAGE(bufoff, gbase, voff) do { _Pragma("unroll") for (int _i = 0; _i < 2; ++_i) \
        __builtin_amdgcn_global_load_lds((const unsigned*)((const char*)(gbase) + (voff)[_i]), (LAS unsigned*)(lds + (bufoff) + ldsw + _i * 8192), 16, 0, 0); } while (0)
#define PG8_LDA(dst, b, h) do { _Pragma("unroll") for (int m = 0; m < 4; ++m) _Pragma("unroll") for (int k = 0; k < 2; ++k) dst[m][k] = *(const LAS bf16x8*)(lds + PG8_SA(b, h) + aoff + m * 2048 + k * 1024); } while (0)
#define PG8_LDB(dst, b, h) do { _Pragma("unroll") for (int n = 0; n < 2; ++n) _Pragma("unroll") for (int k = 0; k < 2; ++k) dst[n][k] = *(const LAS bf16x8*)(lds + PG8_SB(b, h) + boff + n * 2048 + k * 1024); } while (0)
#define PG8_MMA(ai, bj, At, Bt) do { __builtin_amdgcn_s_setprio(1); _Pragma("unroll") for (int m = 0; m < 4; ++m) _Pragma("unroll") for (int n = 0; n < 2; ++n) _Pragma("unroll") for (int k = 0; k < 2; ++k) \
        acc[ai][bj][m][n] = __builtin_amdgcn_mfma_f32_16x16x32_bf16(Bt[n][k], At[m][k], acc[ai][bj][m][n], 0, 0, 0); __builtin_amdgcn_s_setprio(0); } while (0)
#define PG8_WAIT_V(n) asm volatile("s_waitcnt vmcnt(" #n ")" ::: "memory")
#define PG8_WAIT_L(n) asm volatile("s_waitcnt lgkmcnt(" #n ")" ::: "memory")
#define PG8_BAR __builtin_amdgcn_s_barrier()
#define PG8_SCHED __builtin_amdgcn_sched_barrier(0)
    Unit cur, nxt; int ui = 0;
    if (!S.next(0, cur)) return;
    f32x4 acc[2][2][4][2];
#pragma unroll
    for (int a = 0; a < 2; ++a)
#pragma unroll
        for (int b = 0; b < 2; ++b)
#pragma unroll
            for (int m = 0; m < 4; ++m)
#pragma unroll
                for (int n = 0; n < 2; ++n) acc[a][b][m][n] = (f32x4){0.f, 0.f, 0.f, 0.f};
    bf16x8 At[4][2], B0[2][2], B1[2][2];
    const char* cA = (const char*)g.A + (size_t)cur.pm * tstepA + (size_t)cur.k0 * 2;
    const char* cB = (const char*)g.Bt + (size_t)cur.pn * tstepB + (size_t)cur.k0 * 2;
    PG8_STAGE(PG8_SB(0, 0), cB, voffB); PG8_STAGE(PG8_SA(0, 0), cA, voffA); PG8_STAGE(PG8_SB(0, 1), cB + hstepB, voffB); PG8_STAGE(PG8_SA(0, 1), cA + hstepA, voffA);
    if (wr == 1) PG8_BAR;
    PG8_WAIT_V(4); PG8_BAR;
    PG8_STAGE(PG8_SB(1, 0), cB + kstep, voffB); PG8_STAGE(PG8_SA(1, 0), cA + kstep, voffA); PG8_STAGE(PG8_SB(1, 1), cB + hstepB + kstep, voffB);
    PG8_WAIT_V(6); PG8_BAR;
    for (;;) {
        const bool has_next = S.next(ui + 1, nxt);
        const char* nA = has_next ? (const char*)g.A + (size_t)nxt.pm * tstepA + (size_t)nxt.k0 * 2 : cA;
        const char* nB = has_next ? (const char*)g.Bt + (size_t)nxt.pn * tstepB + (size_t)nxt.k0 * 2 : cB;
        const int nt = cur.nt;
        for (int t = 0; t < nt; t += 2) {
            const bool last = (t == nt - 2);
            const char* a1 = cA + (size_t)(t + 1) * kstep;
            const char* a2 = last ? nA : cA + (size_t)(t + 2) * kstep; const char* b2 = last ? nB : cB + (size_t)(t + 2) * kstep;
            const char* a3 = a2 + kstep; const char* b3 = b2 + kstep;
            PG8_LDB(B0, 0, 0); PG8_SCHED; PG8_LDA(At, 0, 0); PG8_STAGE(PG8_SA(1, 1), a1 + hstepA, voffA);
            PG8_WAIT_L(8); PG8_BAR; PG8_WAIT_L(0); PG8_MMA(0, 0, At, B0); PG8_BAR; PG8_SCHED;
            PG8_LDB(B1, 0, 1); PG8_STAGE(PG8_SB(0, 0), b2, voffB);
            PG8_BAR; PG8_WAIT_L(0); PG8_MMA(0, 1, At, B1); PG8_BAR;
            PG8_LDA(At, 0, 1); PG8_STAGE(PG8_SA(0, 0), a2, voffA);
            PG8_BAR; PG8_WAIT_L(0); PG8_MMA(1, 0, At, B0); PG8_BAR; PG8_SCHED;
            PG8_STAGE(PG8_SB(0, 1), b2 + hstepB, voffB);
            PG8_WAIT_V(6); PG8_BAR; PG8_MMA(1, 1, At, B1); PG8_BAR;
            PG8_LDB(B0, 1, 0); PG8_SCHED; PG8_LDA(At, 1, 0); PG8_STAGE(PG8_SA(0, 1), a2 + hstepA, voffA);
            PG8_WAIT_L(8); PG8_BAR; PG8_WAIT_L(0); PG8_MMA(0, 0, At, B0); PG8_BAR; PG8_SCHED;
            PG8_LDB(B1, 1, 1); PG8_STAGE(PG8_SB(1, 0), b3, voffB);
            PG8_BAR; PG8_WAIT_L(0); PG8_MMA(0, 1, At, B1); PG8_BAR;
            PG8_LDA(At, 1, 1); PG8_STAGE(PG8_SA(1, 0), a3, voffA);
            PG8_BAR; PG8_WAIT_L(0); PG8_MMA(1, 0, At, B0); PG8_BAR; PG8_SCHED;
            PG8_STAGE(PG8_SB(1, 1), b3 + hstepB, voffB);
            PG8_WAIT_V(6); PG8_BAR; PG8_MMA(1, 1, At, B1); PG8_BAR;
        }
        MFMA_FENCE();
        if (!cur.skip) E(acc, cur, wr, wc, fr, fq);
        if (!has_next) break;
#pragma unroll
        for (int a = 0; a < 2; ++a)
#pragma unroll
            for (int b = 0; b < 2; ++b)
#pragma unroll
                for (int m = 0; m < 4; ++m)
#pragma unroll
                    for (int n = 0; n < 2; ++n) acc[a][b][m][n] = (f32x4){0.f, 0.f, 0.f, 0.f};
        cur = nxt; cA = nA; cB = nB; ++ui;
    }
    PG8_WAIT_V(0);
    if (wr == 0) PG8_BAR;
    PG8_BAR;
#undef PG8_SA
#undef PG8_SB
#undef PG8_STAGE
#undef PG8_LDA
#undef PG8_LDB
#undef PG8_MMA
#undef PG8_WAIT_V
#undef PG8_WAIT_L
#undef PG8_BAR
#undef PG8_SCHED
}
}
using pg8::Unit;

__device__ __forceinline__ void row_rstd8(float (&rs)[2][4], const float* ss, int rbase, int fq, int nslot4, float inv_n) {
    f32x4 p[2][4];
#pragma unroll
    for (int ai = 0; ai < 2; ++ai)
#pragma unroll
        for (int m = 0; m < 4; ++m) {
            p[ai][m] = (f32x4){0.f, 0.f, 0.f, 0.f};
            if (fq < nslot4) p[ai][m] = *(const f32x4*)(ss + (size_t)(rbase + ai * 128 + m * 16) * 16 + 4 * fq);
        }
#pragma unroll
    for (int ai = 0; ai < 2; ++ai)
#pragma unroll
        for (int m = 0; m < 4; ++m) {
            float t = (p[ai][m][0] + p[ai][m][1]) + (p[ai][m][2] + p[ai][m][3]);
            t += __shfl_xor(t, 16); t += __shfl_xor(t, 32);
            rs[ai][m] = rsqrtf(t * inv_n + EPS);
        }
}

struct EpiSwiglu {
    unsigned char* ws0; int ssi;
    __device__ __forceinline__ void operator()(const f32x4 (&acc)[2][2][4][2], const Unit& u, int wr, int wc, int fr, int fq) const {
        unsigned char* ws = launder(ws0);
        const float* ss = (const float*)(ws + WS_SS) + (size_t)ssi * MPAD * 16; bf16_t* act = (bf16_t*)(ws + WS_ACT);
        const int rbase = u.pm * 256 + wr * 64 + fr;
        float rsv[2][4]; row_rstd8(rsv, ss, rbase, fq, 4, 1.f / 1024.f);
#pragma unroll
        for (int ai = 0; ai < 2; ++ai)
#pragma unroll
            for (int m = 0; m < 4; ++m) {
                const int row = rbase + ai * 128 + m * 16;
                const float rs = rsv[ai][m];
#pragma unroll
                for (int bj = 0; bj < 2; ++bj) {
                    const f32x4 gv = acc[ai][bj][m][0] * rs, uv = acc[ai][bj][m][1] * rs;
                    const int oc = u.pn * 128 + bj * 64 + wc * 16 + 4 * fq;
                    u32x2 w; w.x = pk_bf16(silu(gv[0]) * uv[0], silu(gv[1]) * uv[1]); w.y = pk_bf16(silu(gv[2]) * uv[2], silu(gv[3]) * uv[3]);
                    *(u32x2*)(act + (size_t)row * FFN + oc) = w;
                }
            }
    }
};

struct EpiRes {
    unsigned char* ws0; int ssni, ss5i; float scale;
    __device__ __forceinline__ void operator()(const f32x4 (&acc)[2][2][4][2], const Unit& u, int wr, int wc, int fr, int fq) const {
        unsigned char* ws = launder(ws0);
        float* h32 = (float*)(ws + WS_H32); bf16_t* hb = (bf16_t*)(ws + WS_HB); float* ssn = (float*)(ws + WS_SS) + (size_t)ssni * MPAD * 16;
        const int rbase = u.pm * 256 + wr * 64 + fr;
        if (u.part >= 0) {
            int lo = (wr * 64 + fr) * 256 + wc * 32 + 4 * fq; asm volatile("" : "+v"(lo));
            float* pb = (float*)(ws + WS_PART) + (size_t)(u.kh * 4 + u.part) * 65536 + lo;
#pragma unroll
            for (int ai = 0; ai < 2; ++ai)
#pragma unroll
                for (int m = 0; m < 4; ++m)
#pragma unroll
                    for (int bj = 0; bj < 2; ++bj)
#pragma unroll
                        for (int n = 0; n < 2; ++n)
                            *(f32x4*)(pb + (ai * 128 + m * 16) * 256 + bj * 128 + n * 16) = acc[ai][bj][m][n] * scale;
            return;
        }
        const bool partial = (ss5i >= 0) && (u.kh == 0);
        float rsv[2][4];
        if (ss5i >= 0 && u.kh == 1) row_rstd8(rsv, (const float*)(ws + WS_SS) + (size_t)ss5i * MPAD * 16, rbase, fq, 2, 1.f / 512.f);
        else {
#pragma unroll
            for (int ai = 0; ai < 2; ++ai)
#pragma unroll
                for (int m = 0; m < 4; ++m) rsv[ai][m] = scale;
        }
#pragma unroll
        for (int ai = 0; ai < 2; ++ai) {
            f32x4 hv[4][2][2];
#pragma unroll
            for (int m = 0; m < 4; ++m)
#pragma unroll
                for (int bj = 0; bj < 2; ++bj)
#pragma unroll
                    for (int n = 0; n < 2; ++n)
                        hv[m][bj][n] = *(const f32x4*)(h32 + (size_t)(rbase + ai * 128 + m * 16) * D + u.pn * 256 + bj * 128 + wc * 32 + n * 16 + 4 * fq);
#pragma unroll
            for (int m = 0; m < 4; ++m) {
                const int row = rbase + ai * 128 + m * 16;
                const float sc = rsv[ai][m];
                float s = 0.f;
#pragma unroll
                for (int bj = 0; bj < 2; ++bj)
#pragma unroll
                    for (int n = 0; n < 2; ++n) {
                        const int c = u.pn * 256 + bj * 128 + wc * 32 + n * 16 + 4 * fq;
                        const f32x4 hn = hv[m][bj][n] + acc[ai][bj][m][n] * sc;
                        *(f32x4*)(h32 + (size_t)row * D + c) = hn;
                        if (!partial) {
                            u32x2 w; w.x = pk_bf16(hn[0], hn[1]); w.y = pk_bf16(hn[2], hn[3]);
                            *(u32x2*)(hb + (size_t)row * D + c) = w;
                            s += hn[0] * hn[0] + hn[1] * hn[1] + hn[2] * hn[2] + hn[3] * hn[3];
                        }
                    }
                if (!partial) {
                    s += __shfl_xor(s, 16); s += __shfl_xor(s, 32);
                    if (fq == 0) ssn[(size_t)row * 16 + u.pn * 4 + wc] = s;
                }
            }
        }
    }
};

struct EpiWin {
    unsigned char* ws0; int l;
    __device__ __forceinline__ void operator()(const f32x4 (&acc)[2][2][4][2], const Unit& u, int wr, int wc, int fr, int fq) const {
        unsigned char* ws = launder(ws0);
        const float* ss = (const float*)(ws + WS_SS) + (size_t)(3 * l + 1) * MPAD * 16; const float* lb = (const float*)(ws + WS_LB) + l * 512;
        bf16_t *qt = (bf16_t*)(ws + WS_QT), *kt = (bf16_t*)(ws + WS_KT), *ktT = (bf16_t*)(ws + WS_KTT), *vT = (bf16_t*)(ws + WS_VT), *gs = (bf16_t*)(ws + WS_GS), *ub = (bf16_t*)(ws + WS_UB);
        float *adec = (float*)(ws + WS_ADEC), *adecS = (float*)(ws + WS_ADECS);
        const int rbase = u.pm * 256 + wr * 64 + fr;
        float rsv[2][4]; row_rstd8(rsv, ss, rbase, fq, 4, 1.f / 1024.f);
        f32x4 lbv2[2];
#pragma unroll
        for (int bj = 0; bj < 2; ++bj) lbv2[bj] = *(const f32x4*)(lb + (u.pn & 3) * 128 + bj * 64 + wc * 16 + 4 * fq);
#pragma unroll
        for (int ai = 0; ai < 2; ++ai)
#pragma unroll
            for (int m = 0; m < 4; ++m) {
                const int row = rbase + ai * 128 + m * 16;
                const float rs = rsv[ai][m];
                const bool sample = (row - fr) >= MPROMPT;
                const size_t tb = (size_t)(row >> 4) * 512 * 16 + (row & 15);
                if (u.pn < 4) {
#pragma unroll
                    for (int bj = 0; bj < 2; ++bj) {
                        const int c0 = u.pn * 128 + bj * 64 + wc * 16 + 4 * fq;
                        const f32x4 lbv = lbv2[bj];
                        const f32x4 zq = acc[ai][bj][m][0] * rs, zf = acc[ai][bj][m][1] * rs;
                        f32x4 qv, kv, av;
#pragma unroll
                        for (int e = 0; e < 4; ++e) {
                            const float q = silu(zq[e]);
                            const float sg = sigm(zf[e]);
                            const float f = lbv[e] + (1.f - lbv[e]) * sg;
                            const float kk = (1.f - lbv[e]) * (1.f - sg);
                            const float eb = cumprod16(f, sample, fr);
                            qv[e] = q * eb; kv[e] = kk * frcp(fmaxf(eb, 1.8e-35f)); av[e] = eb;
                        }
                        u32x2 w; w.x = pk_bf16(qv[0], qv[1]); w.y = pk_bf16(qv[2], qv[3]);
                        *(u32x2*)(qt + (size_t)row * 512 + c0) = w;
                        w.x = pk_bf16(kv[0], kv[1]); w.y = pk_bf16(kv[2], kv[3]);
                        *(u32x2*)(kt + (size_t)row * 512 + c0) = w;
#pragma unroll
                        for (int e = 0; e < 4; ++e) ktT[tb + (size_t)(c0 + e) * 16] = to_bf16(kv[e]);
                        if (!sample) { if (fr == 15 && row < MPROMPT) *(f32x4*)(adec + (size_t)(row >> 4) * 512 + c0) = av; }
                        else { if ((fr & 3) == 3 && row < M) *(f32x4*)(adecS + (size_t)((row - MPROMPT) >> 2) * 512 + c0) = av; }
                    }
                } else {
#pragma unroll
                    for (int bj = 0; bj < 2; ++bj)
#pragma unroll
                        for (int n = 0; n < 2; ++n) {
                            const int c = (u.pn & 1) * 256 + bj * 128 + wc * 32 + n * 16 + 4 * fq;
                            const f32x4 v = acc[ai][bj][m][n] * rs;
                            if (u.pn < 6) {
#pragma unroll
                                for (int e = 0; e < 4; ++e) vT[tb + (size_t)(c + e) * 16] = to_bf16(v[e]);
                            } else if (u.pn < 8) {
                                u32x2 w; w.x = pk_bf16(silu(v[0]), silu(v[1])); w.y = pk_bf16(silu(v[2]), silu(v[3]));
                                *(u32x2*)(gs + (size_t)row * 512 + c) = w;
                            } else {
                                u32x2 w; w.x = pk_bf16(v[0], v[1]); w.y = pk_bf16(v[2], v[3]);
                                *(u32x2*)(ub + (size_t)row * 512 + c) = w;
                            }
                        }
                }
            }
    }
};

struct EpiGlu {
    unsigned char* ws0; int l;
    __device__ __forceinline__ void operator()(const f32x4 (&acc)[2][2][4][2], const Unit& u, int wr, int wc, int fr, int fq) const {
        unsigned char* ws = launder(ws0);
        const bf16_t* yg = (const bf16_t*)(ws + WS_YG); const float* bias = gin(23) + l * 512; bf16_t* mixin = (bf16_t*)(ws + WS_MIXIN);
        float* ss5 = (float*)(ws + WS_SS) + (size_t)(13 + l) * MPAD * 16;
        const int rbase = u.pm * 256 + wr * 64 + fr;
        f32x4 bv[2][2];
#pragma unroll
        for (int bj = 0; bj < 2; ++bj)
#pragma unroll
            for (int n = 0; n < 2; ++n) bv[bj][n] = *(const f32x4*)(bias + u.pn * 256 + bj * 128 + wc * 32 + n * 16 + 4 * fq);
#pragma unroll
        for (int ai = 0; ai < 2; ++ai) {
            u32x2 yw[4][2][2];
#pragma unroll
            for (int m = 0; m < 4; ++m)
#pragma unroll
                for (int bj = 0; bj < 2; ++bj)
#pragma unroll
                    for (int n = 0; n < 2; ++n)
                        yw[m][bj][n] = *(const u32x2*)(yg + (size_t)(rbase + ai * 128 + m * 16) * 512 + u.pn * 256 + bj * 128 + wc * 32 + n * 16 + 4 * fq);
#pragma unroll
            for (int m = 0; m < 4; ++m) {
                const int row = rbase + ai * 128 + m * 16;
                float s = 0.f;
#pragma unroll
                for (int bj = 0; bj < 2; ++bj)
#pragma unroll
                    for (int n = 0; n < 2; ++n) {
                        const int c = u.pn * 256 + bj * 128 + wc * 32 + n * 16 + 4 * fq;
                        const f32x4 a = acc[ai][bj][m][n] + bv[bj][n];
                        const u32x2 y2 = yw[m][bj][n];
                        f32x4 o;
                        o[0] = bf16_lo(y2.x) * sigm(a[0]); o[1] = bf16_hi(y2.x) * sigm(a[1]); o[2] = bf16_lo(y2.y) * sigm(a[2]); o[3] = bf16_hi(y2.y) * sigm(a[3]);
                        u32x2 w; w.x = pk_bf16(o[0], o[1]); w.y = pk_bf16(o[2], o[3]);
                        *(u32x2*)(mixin + (size_t)row * 1024 + 512 + c) = w;
                        s += o[0] * o[0] + o[1] * o[1] + o[2] * o[2] + o[3] * o[3];
                    }
                s += __shfl_xor(s, 16); s += __shfl_xor(s, 32);
                if (fq == 0) ss5[(size_t)row * 16 + u.pn * 4 + wc] = s;
            }
        }
    }
};

__device__ __forceinline__ void convert_tile(int t, LAS float* tile, int tid) {
    KP p = kargs(); (void)p;
    const int l = t / 2592; int r = t - l * 2592;
    const float *s0 = nullptr, *s1 = nullptr, *gn = nullptr, *gn2 = nullptr; int K, Nsrc, mode; size_t doff;
    if (r < 704) { mode = 0; s0 = gin(8) + (size_t)l * D * FFN; s1 = gin(9) + (size_t)l * D * FFN; gn = gin(7) + l * D; K = D; Nsrc = FFN; doff = WL_A1; }
    else if ((r -= 704) < 352) { mode = 1; s0 = gin(10) + (size_t)l * FFN * D; K = FFN; Nsrc = D; doff = WL_D1; }
    else if ((r -= 352) < 704) { mode = 0; s0 = gin(27) + (size_t)l * D * FFN; s1 = gin(28) + (size_t)l * D * FFN; gn = gin(26) + l * D; K = D; Nsrc = FFN; doff = WL_A2; }
    else if ((r -= 704) < 352) { mode = 1; s0 = gin(29) + (size_t)l * FFN * D; K = FFN; Nsrc = D; doff = WL_D2; }
    else if ((r -= 352) < 320) { mode = 2; s0 = gin(12) + (size_t)l * D * INC; gn = gin(11) + l * D; K = D; Nsrc = INC; doff = WL_IN; }
    else if ((r -= 320) < 32) { mode = 1; s0 = gin(22) + (size_t)l * 512 * 512; K = 512; Nsrc = 512; doff = WL_GLU; }
    else { r -= 32; mode = 3; s0 = gin(25) + (size_t)l * D * D; gn = gin(13) + l * 512; gn2 = gin(24) + l * 512; K = D; Nsrc = D; doff = WL_OUT; }
    bf16_t* dst = (bf16_t*)(gws() + WS_W + (size_t)l * WL_SZ + doff);
    const int nkt = K / 128, ntile = r / nkt, kt = r - ntile * nkt, n0 = ntile * 64, k0 = kt * 128;
    const int rr = tid & 63, np = n0 + rr;
    const float* src = s0; int col = np;
    if (mode == 0) { const int j = np >> 5, half = (np >> 4) & 1; col = 16 * j + (np & 15); src = half ? s1 : s0; }
    else if (mode == 2 && np < 1024) { const int j = np >> 5, half = (np >> 4) & 1, c = 16 * j + (np & 15); col = half ? 512 + c : c; }
    float v[16];
#pragma unroll
    for (int it = 0; it < 16; ++it) v[it] = src[(size_t)(k0 + (tid >> 6) + 8 * it) * Nsrc + col];
#pragma unroll
    for (int it = 0; it < 16; ++it) {
        const int kk = (tid >> 6) + 8 * it, k = k0 + kk;
        float x = v[it];
        if (mode == 0 || mode == 2) x *= gn[k];
        else if (mode == 3) x *= (k < 512 ? gn[k] : gn2[k - 512]);
        tile[kk * 65 + rr] = x;
    }
    __syncthreads();
    { const int r2 = tid >> 3, kc = tid & 7; float f[16];
#pragma unroll
      for (int j = 0; j < 16; ++j) f[j] = tile[(kc * 16 + j) * 65 + r2];
      u32x4 w0, w1; w0.x = pk_bf16(f[0], f[1]); w0.y = pk_bf16(f[2], f[3]); w0.z = pk_bf16(f[4], f[5]); w0.w = pk_bf16(f[6], f[7]);
      w1.x = pk_bf16(f[8], f[9]); w1.y = pk_bf16(f[10], f[11]); w1.z = pk_bf16(f[12], f[13]); w1.w = pk_bf16(f[14], f[15]);
      u32x4* dp = (u32x4*)(dst + (size_t)(n0 + r2) * K + k0 + kc * 16); dp[0] = w0; dp[1] = w1; }
    __syncthreads();
}
__device__ __forceinline__ void p0_init(LAS unsigned char* lds, int G, int bid, int tid) {
    const int wave = tid >> 6, lane = tid & 63;
    float* h32 = (float*)(gws() + WS_H32); bf16_t* hb = (bf16_t*)(gws() + WS_HB); float* ss = (float*)(gws() + WS_SS);
    for (int row = bid * 8 + wave; row < MPAD; row += G * 8) {
        const float* src = nullptr;
        if (row < MPROMPT) { const int b = row / LP, pos = row - b * LP; src = pos < 16 ? gin(5) + (size_t)pos * D : gin(0) + ((size_t)b * SEQ + pos - 16) * D; }
        else if (row < M) src = gin(1) + (size_t)(row - MPROMPT) * D;
        float s = 0.f;
#pragma unroll
        for (int i = 0; i < 4; ++i) {
            const int c = (i * 64 + lane) * 4;
            f32x4 v = (f32x4){0.f, 0.f, 0.f, 0.f};
            if (src) v = *(const f32x4*)(src + c);
            *(f32x4*)(h32 + (size_t)row * D + c) = v;
            u32x2 w; w.x = pk_bf16(v[0], v[1]); w.y = pk_bf16(v[2], v[3]);
            *(u32x2*)(hb + (size_t)row * D + c) = w;
            s += v[0] * v[0] + v[1] * v[1] + v[2] * v[2] + v[3] * v[3];
        }
#pragma unroll
        for (int o = 32; o > 0; o >>= 1) s += __shfl_xor(s, o);
        if (lane < 16) ss[(size_t)row * 16 + lane] = (lane == 0) ? s : 0.f;
    }
    const int gt = bid * NTHREADS + tid;
    if (gt < 512) {
        float v[4], mx = -1e30f;
        for (int l = 0; l < 4; ++l) { v[l] = gin(6)[l * 512 + gt]; mx = fmaxf(mx, v[l]); }
        float sum = 0.f; for (int l = 0; l < 4; ++l) { v[l] = expf(v[l] - mx); sum += v[l]; }
        float* lb = (float*)(gws() + WS_LB); float c = 0.f;
        for (int l = 0; l < 4; ++l) { lb[l * 512 + gt] = c; if (l < 3) c += v[l + 1] / sum; }
    }
    {
        const int i = gt - 512;
        if (i >= 0 && i < 4 * 32 * 64) {
            const int pidx = i & 63, lg = i >> 6;
            const float dt = expf(gin(16)[lg]);
            const float lr = fminf(gin(14)[i], -1e-4f), li = gin(15)[i];
            const float mag = expf(lr * dt), ar = mag * cosf(li * dt), ai = mag * sinf(li * dt);
            const float den = lr * lr + li * li;
            const float cr = ((ar - 1.f) * lr + ai * li) / den, ci = (ai * lr - (ar - 1.f) * li) / den;
            ((f32x2*)(gws() + WS_ABAR))[i] = (f32x2){ar, ai};
            bf16_t* bbT = (bf16_t*)(gws() + WS_BBT); bf16_t* cT = (bf16_t*)(gws() + WS_CT);
            for (int h = 0; h < 16; ++h) {
                const float br = gin(17)[(size_t)i * 16 + h], bi = gin(18)[(size_t)i * 16 + h];
                bbT[((size_t)lg * 128 + 2 * pidx) * 16 + h] = to_bf16(cr * br - ci * bi);
                bbT[((size_t)lg * 128 + 2 * pidx + 1) * 16 + h] = to_bf16(cr * bi + ci * br);
                cT[((size_t)lg * 16 + h) * 128 + 2 * pidx] = to_bf16(gin(19)[((size_t)lg * 16 + h) * 64 + pidx]);
                cT[((size_t)lg * 16 + h) * 128 + 2 * pidx + 1] = to_bf16(-gin(20)[((size_t)lg * 16 + h) * 64 + pidx]);
            }
        }
    }
    for (int t = bid; t < 4 * 2592; t += G) convert_tile(t, (LAS float*)lds, tid);
}

__device__ __forceinline__ void hgrn_core(const bf16x8 (&q)[4], const bf16x8 (&k)[4], const bf16x4 (&kT)[8], const bf16x4 v, const f32x4 (&av)[8],
                                          f32x4 (&S)[8], float* orow, f32x4& oout, bool sample, int fqm, int fr, int fq) {
    f32x4 sc = (f32x4){0.f, 0.f, 0.f, 0.f};
#pragma unroll
    for (int kk = 0; kk < 4; ++kk) sc = mfma32(k[kk], q[kk], sc);
    MFMA_FENCE();
#pragma unroll
    for (int i = 0; i < 4; ++i) { bool keep = (4 * fq + i) <= fr; if (sample) keep = keep && (fq == (fr >> 2)); sc[i] = keep ? sc[i] : 0.f; }
    u32x2 pw; pw.x = pk_bf16(sc[0], sc[1]); pw.y = pk_bf16(sc[2], sc[3]);
    f32x4 o = mfma16(__builtin_bit_cast(bf16x4, pw), v, (f32x4){0.f, 0.f, 0.f, 0.f});
#pragma unroll
    for (int kk = 0; kk < 4; ++kk) {
        u32x4 sb; sb.x = pk_bf16(S[2 * kk][0], S[2 * kk][1]); sb.y = pk_bf16(S[2 * kk][2], S[2 * kk][3]);
        sb.z = pk_bf16(S[2 * kk + 1][0], S[2 * kk + 1][1]); sb.w = pk_bf16(S[2 * kk + 1][2], S[2 * kk + 1][3]);
        o = mfma32(q[kk], __builtin_bit_cast(bf16x8, sb), o);
    }
    MFMA_FENCE();
    oout = o;
    if (orow != nullptr && (!sample || fq == fqm)) {
#pragma unroll
        for (int i = 0; i < 4; ++i) orow[(size_t)(4 * fq + i) * 512] = o[i];
    }
#pragma unroll
    for (int blk = 0; blk < 8; ++blk) {
        bf16x4 kt = kT[blk];
        if (sample && fq != fqm) kt = (bf16x4){0, 0, 0, 0};
        S[blk] = mfma16(kt, v, S[blk]);
    }
    MFMA_FENCE();
#pragma unroll
    for (int blk = 0; blk < 8; ++blk) S[blk] *= av[blk];
}
__device__ __forceinline__ void hgrn_sample_item(int l, int b, int h, int wave, int lane) {
    const int fr = lane & 15, fq = lane >> 4, cb = 128 * h, v0 = cb + 16 * wave;
    const bf16_t* qt = (const bf16_t*)(gws() + WS_QT); const bf16_t* kt = (const bf16_t*)(gws() + WS_KT);
    const bf16_t* ktT = (const bf16_t*)(gws() + WS_KTT); const bf16_t* vT = (const bf16_t*)(gws() + WS_VT);
    float* oraw = (float*)(gws() + WS_ORAW);
    const int R0 = MPROMPT + 4 * b, r0 = R0 & ~15, fqm = b & 3;
    f32x4 S[8];
    const float* s0 = gin(2) + (((size_t)l * 128 + b) * 4 + h) * 16384;
#pragma unroll
    for (int blk = 0; blk < 8; ++blk)
#pragma unroll
        for (int i = 0; i < 4; ++i) S[blk][i] = s0[(size_t)(16 * blk + 4 * fq + i) * 128 + 16 * wave + fr];
    bf16x8 q[4], k[4]; bf16x4 kT[8], v; f32x4 av[8];
    const size_t ro = (size_t)(r0 + fr) * 512 + cb + 4 * fq;
#pragma unroll
    for (int kk = 0; kk < 4; ++kk) {
        const u32x2 a0 = *(const u32x2*)(qt + ro + 32 * kk), a1 = *(const u32x2*)(qt + ro + 32 * kk + 16);
        const u32x2 b0 = *(const u32x2*)(kt + ro + 32 * kk), b1 = *(const u32x2*)(kt + ro + 32 * kk + 16);
        q[kk] = __builtin_bit_cast(bf16x8, ((u32x4){a0.x, a0.y, a1.x, a1.y})); k[kk] = __builtin_bit_cast(bf16x8, ((u32x4){b0.x, b0.y, b1.x, b1.y}));
    }
    const size_t to = (size_t)(r0 >> 4) * 512 * 16 + 4 * fq;
    const float* ap = (const float*)(gws() + WS_ADECS) + (size_t)b * 512 + cb + 4 * fq;
#pragma unroll
    for (int blk = 0; blk < 8; ++blk) { kT[blk] = *(const bf16x4*)(ktT + to + (size_t)(cb + 16 * blk + fr) * 16); av[blk] = *(const f32x4*)(ap + 16 * blk); }
    v = *(const bf16x4*)(vT + to + (size_t)(v0 + fr) * 16);
    f32x4 odummy;
    hgrn_core(q, k, kT, v, av, S, oraw + (size_t)r0 * 512 + v0 + fr, odummy, true, fqm, fr, fq);
    float* so = gout() + O_HGS + (((size_t)l * 128 + b) * 4 + h) * 16384;
#pragma unroll
    for (int blk = 0; blk < 8; ++blk)
#pragma unroll
        for (int i = 0; i < 4; ++i) so[(size_t)(16 * blk + 4 * fq + i) * 128 + 16 * wave + fr] = S[blk][i];
}
constexpr int HST = 16896, HNS = 7;
__device__ __forceinline__ void hgrn_issue(LAS unsigned char* lds, int ci, int row0, int cb, int wave, int lane) {
    const int cc = ci < 129 ? ci : 128, r0 = row0 + 16 * cc, chunk = r0 >> 4;
    LAS unsigned char* st = lds + (ci % HNS) * HST;
    const unsigned char* ws = gws();
    const int w4 = wave - 4, t = w4 * 64 + lane, row = t >> 4, c = (t & 15) ^ row;
    const size_t rowoff = ((size_t)(r0 + row) * 512 + cb + c * 8) * 2, toff = ((size_t)chunk * 512 + cb) * 32 + (size_t)t * 16;
    __builtin_amdgcn_global_load_lds((const unsigned*)(ws + WS_QT + rowoff), (LAS unsigned*)(st + w4 * 1024), 16, 0, 0);
    __builtin_amdgcn_global_load_lds((const unsigned*)(ws + WS_KT + rowoff), (LAS unsigned*)(st + 4096 + w4 * 1024), 16, 0, 0);
    __builtin_amdgcn_global_load_lds((const unsigned*)(ws + WS_KTT + toff), (LAS unsigned*)(st + 8192 + w4 * 1024), 16, 0, 0);
    __builtin_amdgcn_global_load_lds((const unsigned*)(ws + WS_VT + toff), (LAS unsigned*)(st + 12288 + w4 * 1024), 16, 0, 0);
    if (wave == 4 && lane < 32)
        __builtin_amdgcn_global_load_lds((const unsigned*)(ws + WS_ADEC + ((size_t)chunk * 512 + cb) * 4 + lane * 16), (LAS unsigned*)(st + 16384), 16, 0, 0);
}
__device__ __forceinline__ void hgrn_scores(LAS const unsigned char* st, LAS unsigned char* pb, int lane) {
    const int fr = lane & 15, fq = lane >> 4;
    f32x4 sc = (f32x4){0.f, 0.f, 0.f, 0.f};
#pragma unroll
    for (int kk = 0; kk < 4; ++kk) {
        const int e0 = 32 * kk + 4 * fq, e1 = e0 + 16;
        const int o0 = fr * 256 + (((e0 >> 3) ^ fr) << 4) + (e0 & 7) * 2, o1 = fr * 256 + (((e1 >> 3) ^ fr) << 4) + (e1 & 7) * 2;
        const u32x2 a0 = *(LAS const u32x2*)(st + o0), a1 = *(LAS const u32x2*)(st + o1);
        const u32x2 b0 = *(LAS const u32x2*)(st + 4096 + o0), b1 = *(LAS const u32x2*)(st + 4096 + o1);
        sc = mfma32(__builtin_bit_cast(bf16x8, ((u32x4){b0.x, b0.y, b1.x, b1.y})), __builtin_bit_cast(bf16x8, ((u32x4){a0.x, a0.y, a1.x, a1.y})), sc);
    }
    MFMA_FENCE();
#pragma unroll
    for (int i = 0; i < 4; ++i) sc[i] = ((4 * fq + i) <= fr) ? sc[i] : 0.f;
    u32x2 pw; pw.x = pk_bf16(sc[0], sc[1]); pw.y = pk_bf16(sc[2], sc[3]);
    *(LAS u32x2*)(pb + lane * 8) = pw;
}
__device__ __forceinline__ void hgrn_core_p(const bf16x8 (&q)[4], const bf16x4 P, const bf16x4 (&kT)[8], const bf16x4 v, const f32x4 (&av)[8], f32x4 (&S)[8], f32x4& oout) {
    f32x4 o = mfma16(P, v, (f32x4){0.f, 0.f, 0.f, 0.f});
#pragma unroll
    for (int kk = 0; kk < 4; ++kk) {
        u32x4 sb; sb.x = pk_bf16(S[2 * kk][0], S[2 * kk][1]); sb.y = pk_bf16(S[2 * kk][2], S[2 * kk][3]);
        sb.z = pk_bf16(S[2 * kk + 1][0], S[2 * kk + 1][1]); sb.w = pk_bf16(S[2 * kk + 1][2], S[2 * kk + 1][3]);
        o = mfma32(q[kk], __builtin_bit_cast(bf16x8, sb), o);
    }
#pragma unroll
    for (int blk = 0; blk < 8; ++blk) S[blk] = mfma16(kT[blk], v, S[blk]);
    MFMA_FENCE();
    oout = o;
#pragma unroll
    for (int blk = 0; blk < 8; ++blk) S[blk] *= av[blk];
}
__device__ __forceinline__ void hgrn_prompt_item(int l, int b, int h, int half, LAS unsigned char* lds, int tid, int wave, int lane) {
    const int fr = lane & 15, fq = lane >> 4, cb_ = 128 * h, vloc = 64 * half + 16 * (wave & 3), v0 = cb_ + vloc, row0 = b * LP;
    const bool comp = wave < 4;
    LAS unsigned char* pbuf = lds + HNS * HST;
    float* oraw = (float*)(gws() + WS_ORAW);
    f32x4 S[8];
#pragma unroll
    for (int blk = 0; blk < 8; ++blk) S[blk] = (f32x4){0.f, 0.f, 0.f, 0.f};
    if (!comp) {
        for (int ci = 0; ci < HNS - 1; ++ci) hgrn_issue(lds, ci, row0, cb_, wave, lane);
        if (wave == 4) asm volatile("s_waitcnt vmcnt(25)" ::: "memory"); else asm volatile("s_waitcnt vmcnt(20)" ::: "memory");
    }
    __builtin_amdgcn_s_barrier();
    asm volatile("" ::: "memory");
    if (wave == 5) { hgrn_scores(lds, pbuf, lane); LGKM0(); }
    f32x4 ob[4];
    for (int cb = 0; cb < 129; cb += 4) {
#pragma unroll
        for (int j = 0; j < 4; ++j) {
            const int ci = cb + j;
            if (ci < 129) {
                if (wave == 4) asm volatile("s_waitcnt vmcnt(20)" ::: "memory"); else if (wave > 4) asm volatile("s_waitcnt vmcnt(16)" ::: "memory");
                __builtin_amdgcn_s_barrier();
                asm volatile("" ::: "memory");
                if (comp) {
                    if (j == 0 && cb > 0) {
#pragma unroll
                        for (int jj = 0; jj < 4; ++jj)
#pragma unroll
                            for (int i = 0; i < 4; ++i) oraw[(size_t)(row0 + 16 * (cb - 4 + jj) + 4 * fq + i) * 512 + v0 + fr] = ob[jj][i];
                    }
                    LAS const unsigned char* st = lds + (ci % HNS) * HST;
                    bf16x8 q[4]; bf16x4 kT[8], v; f32x4 av[8];
#pragma unroll
                    for (int kk = 0; kk < 4; ++kk) {
                        const int e0 = 32 * kk + 4 * fq, e1 = e0 + 16;
                        const int o0 = fr * 256 + (((e0 >> 3) ^ fr) << 4) + (e0 & 7) * 2, o1 = fr * 256 + (((e1 >> 3) ^ fr) << 4) + (e1 & 7) * 2;
                        const u32x2 a0 = *(LAS const u32x2*)(st + o0), a1 = *(LAS const u32x2*)(st + o1);
                        q[kk] = __builtin_bit_cast(bf16x8, ((u32x4){a0.x, a0.y, a1.x, a1.y}));
                    }
#pragma unroll
                    for (int blk = 0; blk < 8; ++blk) {
                        kT[blk] = *(LAS const bf16x4*)(st + 8192 + (16 * blk + fr) * 32 + 8 * fq);
                        av[blk] = *(LAS const f32x4*)(st + 16384 + (16 * blk + 4 * fq) * 4);
                    }
                    v = *(LAS const bf16x4*)(st + 12288 + (vloc + fr) * 32 + 8 * fq);
                    const bf16x4 P = *(LAS const bf16x4*)(pbuf + (ci & 1) * 512 + lane * 8);
                    hgrn_core_p(q, P, kT, v, av, S, ob[j]);
                } else {
                    hgrn_issue(lds, ci + HNS - 1, row0, cb_, wave, lane);
                    if (wave == 5 && ci + 1 < 129) { hgrn_scores(lds + ((ci + 1) % HNS) * HST, pbuf + ((ci + 1) & 1) * 512, lane); LGKM0(); }
                }
            }
        }
    }
    if (comp) {
#pragma unroll
        for (int i = 0; i < 4; ++i) oraw[(size_t)(row0 + 16 * 128 + 4 * fq + i) * 512 + v0 + fr] = ob[0][i];
    }
    asm volatile("s_waitcnt vmcnt(0)" ::: "memory");
    __syncthreads();
    if (comp) {
        float* so = gout() + O_HGP + (((size_t)l * 8 + b) * 4 + h) * 16384;
#pragma unroll
        for (int blk = 0; blk < 8; ++blk)
#pragma unroll
            for (int i = 0; i < 4; ++i) so[(size_t)(16 * blk + 4 * fq + i) * 128 + vloc + fr] = S[blk][i];
    }
}

struct S5C { bf16x4 Bb[8]; bf16x8 Cf[4]; float ar, ai, dsk; };
__device__ __forceinline__ void s5_load_const(S5C& c, int l, int g, int lane) {
    const int fr = lane & 15, fq = lane >> 4, lg = l * 32 + g;
    const bf16_t* bbT = (const bf16_t*)(gws() + WS_BBT); const bf16_t* cT = (const bf16_t*)(gws() + WS_CT);
#pragma unroll
    for (int blk = 0; blk < 8; ++blk) c.Bb[blk] = *(const bf16x4*)(bbT + ((size_t)lg * 128 + 16 * blk + fr) * 16 + 4 * fq);
#pragma unroll
    for (int kk = 0; kk < 4; ++kk) c.Cf[kk] = *(const bf16x8*)(cT + ((size_t)lg * 16 + fr) * 128 + 32 * kk + 8 * fq);
    const f32x2 a = ((const f32x2*)(gws() + WS_ABAR))[lg * 64 + lane];
    c.ar = a.x; c.ai = a.y; c.dsk = gin(21)[lg * 16 + fr];
}
__device__ __forceinline__ bf16x4 s5_ua(const bf16_t* ub, int r0, int g, int fr, int fq) { return *(const bf16x4*)(ub + (size_t)(r0 + fr) * 512 + 16 * g + 4 * fq); }
__device__ __forceinline__ void s5_bu_v(const S5C& c, const bf16x4 ua, LAS float* bu, int fr, int fq);
__device__ __forceinline__ void s5_bu(const S5C& c, const bf16_t* ub, int r0, int g, LAS float* bu, int fr, int fq) { s5_bu_v(c, s5_ua(ub, r0, g, fr, fq), bu, fr, fq); }
__device__ __forceinline__ void s5_bu_v(const S5C& c, const bf16x4 ua, LAS float* bu, int fr, int fq) {
    f32x4 d[8];
#pragma unroll
    for (int blk = 0; blk < 8; ++blk) d[blk] = mfma16(ua, c.Bb[blk], (f32x4){0.f, 0.f, 0.f, 0.f});
    MFMA_FENCE();
#pragma unroll
    for (int blk = 0; blk < 8; ++blk)
#pragma unroll
        for (int i = 0; i < 4; ++i) bu[(4 * fq + i) * 132 + 16 * blk + fr] = d[blk][i];
}
__device__ __forceinline__ void s5_uu(unsigned (&uu)[4], const bf16_t* ub, int r0, int g, int fr, int fq) {
#pragma unroll
    for (int i = 0; i < 4; ++i) uu[i] = ub[(size_t)(r0 + 4 * fq + i) * 512 + 16 * g + fr];
}
__device__ __forceinline__ void s5_y(const S5C& c, const unsigned (&uu)[4], bf16_t* yg, int r0, int g, LAS const bf16_t* xs, int fr, int fq) {
    f32x4 y = (f32x4){0.f, 0.f, 0.f, 0.f};
#pragma unroll
    for (int kk = 0; kk < 4; ++kk) { const bf16x8 a = *(LAS const bf16x8*)(xs + fr * 136 + 32 * kk + 8 * fq); y = mfma32(a, c.Cf[kk], y); }
    MFMA_FENCE();
#pragma unroll
    for (int i = 0; i < 4; ++i) {
        const size_t o = (size_t)(r0 + 4 * fq + i) * 512 + 16 * g + fr;
        const float uf = __uint_as_float(uu[i] << 16);
        yg[o] = to_bf16(gelu_tanh(y[i] + c.dsk * uf));
    }
}
__device__ __forceinline__ void s5_prompt_item(int l, int b, int g, LAS unsigned char* lds, int wave, int lane) {
    const int fr = lane & 15, fq = lane >> 4;
    LAS float* bu = (LAS float*)(lds + wave * 12800); LAS bf16_t* xs = (LAS bf16_t*)(lds + wave * 12800 + 8448);
    LAS float* carr = (LAS float*)(lds + 8 * 12800);
    const bf16_t* ub = (const bf16_t*)(gws() + WS_UB); bf16_t* yg = (bf16_t*)(gws() + WS_YG);
    S5C c; s5_load_const(c, l, g, lane);
    const int c0 = 16 * wave, c1 = (wave == 7) ? 129 : 16 * wave + 16, row0 = b * LP;
#ifdef DIAG_NO_S5
    for (int ci = c0; ci < c1; ++ci) for (int i = 0; i < 4; ++i) yg[(size_t)(row0 + 16 * ci + 4 * fq + i) * 512 + 16 * g + fr] = 0;
    if (wave == 7) { const size_t o = (((size_t)l * 8 + b) * 32 + g) * 64 + lane; gout()[O_S5RP + o] = 0.f; gout()[O_S5IP + o] = 0.f; }
    return;
#endif
    float xr = 0.f, xi = 0.f;
    if (wave < 7) {
        bf16x4 ua_n = s5_ua(ub, row0 + 16 * c0, g, fr, fq);
        for (int ci = c0; ci < c1; ++ci) {
            const bf16x4 ua = ua_n;
            ua_n = s5_ua(ub, row0 + 16 * (ci + 1 < c1 ? ci + 1 : ci), g, fr, fq);
            s5_bu_v(c, ua, bu, fr, fq);
            LGKM0();
            f32x2 bv[16];
#pragma unroll
            for (int t = 0; t < 16; ++t) bv[t] = *(LAS const f32x2*)(bu + t * 132 + 2 * lane);
#pragma unroll
            for (int t = 0; t < 16; ++t) { const float nr = c.ar * xr - c.ai * xi + bv[t].x, ni = c.ar * xi + c.ai * xr + bv[t].y; xr = nr; xi = ni; }
            LGKM0();
        }
    }
    carr[(wave * 64 + lane) * 2] = xr; carr[(wave * 64 + lane) * 2 + 1] = xi;
    __syncthreads();
    float pr = c.ar, pi = c.ai;
#pragma unroll
    for (int s = 0; s < 8; ++s) { const float nr = pr * pr - pi * pi, ni = 2.f * pr * pi; pr = nr; pi = ni; }
    xr = 0.f; xi = 0.f;
    for (int w = 0; w < wave; ++w) {
        const float lr = carr[(w * 64 + lane) * 2], li = carr[(w * 64 + lane) * 2 + 1];
        const float nr = pr * xr - pi * xi + lr, ni = pr * xi + pi * xr + li; xr = nr; xi = ni;
    }
    bf16x4 ua_n = s5_ua(ub, row0 + 16 * c0, g, fr, fq); unsigned uu_n[4]; s5_uu(uu_n, ub, row0 + 16 * c0, g, fr, fq);
    for (int ci = c0; ci < c1; ++ci) {
        const int r0 = row0 + 16 * ci, rn = row0 + 16 * (ci + 1 < c1 ? ci + 1 : ci);
        const bf16x4 ua = ua_n; unsigned uu[4];
#pragma unroll
        for (int i = 0; i < 4; ++i) uu[i] = uu_n[i];
        ua_n = s5_ua(ub, rn, g, fr, fq); s5_uu(uu_n, ub, rn, g, fr, fq);
        s5_bu_v(c, ua, bu, fr, fq);
        LGKM0();
        f32x2 bv[16]; unsigned xp[16];
#pragma unroll
        for (int t = 0; t < 16; ++t) bv[t] = *(LAS const f32x2*)(bu + t * 132 + 2 * lane);
#pragma unroll
        for (int t = 0; t < 16; ++t) { const float nr = c.ar * xr - c.ai * xi + bv[t].x, ni = c.ar * xi + c.ai * xr + bv[t].y; xr = nr; xi = ni; xp[t] = pk_bf16(xr, xi); }
#pragma unroll
        for (int t = 0; t < 16; ++t) *(LAS unsigned*)(xs + t * 136 + 2 * lane) = xp[t];
        LGKM0();
        s5_y(c, uu, yg, r0, g, xs, fr, fq);
        LGKM0();
    }
    if (wave == 7) {
        const size_t o = (((size_t)l * 8 + b) * 32 + g) * 64 + lane;
        gout()[O_S5RP + o] = xr; gout()[O_S5IP + o] = xi;
    }
    __syncthreads();
}
__device__ __forceinline__ void s5_sample_wave(int l, int bblk, int g, LAS unsigned char* lds, int wave, int lane) {
    const int fr = lane & 15, fq = lane >> 4;
    LAS float* bu = (LAS float*)(lds + wave * 12800); LAS bf16_t* xs = (LAS bf16_t*)(lds + wave * 12800 + 8448);
    const bf16_t* ub = (const bf16_t*)(gws() + WS_UB); bf16_t* yg = (bf16_t*)(gws() + WS_YG);
    S5C c; s5_load_const(c, l, g, lane);
    const int r0 = MPROMPT + 16 * bblk;
#ifdef DIAG_NO_S5
    for (int i = 0; i < 4; ++i) yg[(size_t)(r0 + 4 * fq + i) * 512 + 16 * g + fr] = 0;
    for (int s = 0; s < 4; ++s) { const size_t o = (((size_t)l * 128 + 4 * bblk + s) * 32 + g) * 64 + lane; gout()[O_S5RS + o] = 0.f; gout()[O_S5IS + o] = 0.f; }
    return;
#endif
    unsigned uu[4]; s5_uu(uu, ub, r0, g, fr, fq);
    s5_bu(c, ub, r0, g, bu, fr, fq);
    LGKM0();
#pragma unroll
    for (int s = 0; s < 4; ++s) {
        const int b = 4 * bblk + s;
        const size_t o = (((size_t)l * 128 + b) * 32 + g) * 64 + lane;
        float xr = gin(3)[o], xi = gin(4)[o];
#pragma unroll
        for (int tt = 0; tt < 4; ++tt) {
            const int t = 4 * s + tt;
            const f32x2 bv = *(LAS const f32x2*)(bu + t * 132 + 2 * lane);
            const float nr = c.ar * xr - c.ai * xi + bv.x, ni = c.ar * xi + c.ai * xr + bv.y; xr = nr; xi = ni;
            *(LAS unsigned*)(xs + t * 136 + 2 * lane) = pk_bf16(xr, xi);
        }
        gout()[O_S5RS + o] = xr; gout()[O_S5IS + o] = xi;
    }
    LGKM0();
    s5_y(c, uu, yg, r0, g, xs, fr, fq);
    LGKM0();
}

#define BW_XCNT(x) (32 * (x))
#define BW_XSUB(x) (32 * (16 + (x)))
#define BW_XGEN(x) (32 * (32 + (x)))
#define BW_TOP (32 * 48)
#define BW_TOPGEN (32 * 49)
__device__ __forceinline__ unsigned bw_ld(unsigned* p) { return __hip_atomic_load(p, __ATOMIC_RELAXED, __HIP_MEMORY_SCOPE_AGENT); }
__device__ __forceinline__ unsigned bw_add(unsigned* p, unsigned v) { return __hip_atomic_fetch_add(p, v, __ATOMIC_RELAXED, __HIP_MEMORY_SCOPE_AGENT); }
__device__ __forceinline__ unsigned xcc_id() { return (unsigned)__builtin_amdgcn_s_getreg((3 << 11) | 20) & 0xFu; }
#define BW_SPIN(cond) do { unsigned _sp = 0; while (cond) { __builtin_amdgcn_s_sleep(1); if (++_sp > (1u << 22)) break; } } while (0)
__device__ __forceinline__ void fast_grid_barrier(unsigned* bar, unsigned k, unsigned x, unsigned nloc, unsigned nx, int tidnow) {
    asm volatile("s_waitcnt vmcnt(0) lgkmcnt(0)" ::: "memory");
    __syncthreads();
    if (tidnow == 0) {
        const unsigned old = bw_add(&bar[BW_XSUB(x)], 1u);
        if (old + 1u == k * nloc) {
            __builtin_amdgcn_fence(__ATOMIC_RELEASE, "agent");
            asm volatile("s_waitcnt vmcnt(0)" ::: "memory");
            const unsigned og = bw_add(&bar[BW_TOP], 1u);
            if (og + 1u == k * nx) bw_add(&bar[BW_TOPGEN], 1u);
            else BW_SPIN(bw_ld(&bar[BW_TOPGEN]) < k);
            __builtin_amdgcn_fence(__ATOMIC_ACQUIRE, "agent");
            bw_add(&bar[BW_XGEN(x)], 1u);
            asm volatile("s_waitcnt vmcnt(0)" ::: "memory");
        } else {
            BW_SPIN(bw_ld(&bar[BW_XGEN(x)]) < k);
            __builtin_amdgcn_fence(__ATOMIC_ACQUIRE, "agent");
            asm volatile("s_waitcnt vmcnt(0)" ::: "memory");
        }
    }
    __syncthreads();
}
__device__ __forceinline__ void finish_remainder(unsigned char* ws, int ssni, int ss5i, int bid, int G, int wave, int lane) {
    pg8::Order S; S.init(MPAD / 256, D / 256, G, bid, 1, 512);
    float* h32 = (float*)(ws + WS_H32); bf16_t* hbw = (bf16_t*)(ws + WS_HB);
    float* ssn = (float*)(ws + WS_SS) + (size_t)ssni * MPAD * 16;
    const int nrem = S.nwg - G;
    for (int task = bid * 8 + wave; task < nrem * 256; task += G * 8) {
        int pm, pn; S.tile_of(G + (task >> 8), pm, pn);
        const int row = pm * 256 + (task & 255), c = pn * 256 + lane * 4;
        f32x4 v = *(const f32x4*)(h32 + (size_t)row * D + c);
        const float* pb = (const float*)(ws + WS_PART) + (size_t)(task >> 8) * 4 * 65536 + (size_t)(task & 255) * 256 + lane * 4;
        const f32x4 p0 = *(const f32x4*)(pb), p1 = *(const f32x4*)(pb + 65536), p2 = *(const f32x4*)(pb + 2 * 65536), p3 = *(const f32x4*)(pb + 3 * 65536);
        float sc = 1.f;
        if (ss5i >= 0) sc = rsqrtf(row_ss8((const float*)(ws + WS_SS) + (size_t)ss5i * MPAD * 16, row) * (1.f / 512.f) + EPS);
        v += (p0 + p1) + (p2 + p3) * sc;
        *(f32x4*)(h32 + (size_t)row * D + c) = v;
        u32x2 w; w.x = pk_bf16(v[0], v[1]); w.y = pk_bf16(v[2], v[3]);
        *(u32x2*)(hbw + (size_t)row * D + c) = w;
        float sq = v[0] * v[0] + v[1] * v[1] + v[2] * v[2] + v[3] * v[3];
#pragma unroll
        for (int o = 32; o > 0; o >>= 1) sq += __shfl_xor(sq, o);
        if (lane < 4) ssn[(size_t)row * 16 + pn * 4 + lane] = (lane == 0) ? sq : 0.f;
    }
}
#define GRID_SYNC() do { asm volatile("s_waitcnt vmcnt(0) lgkmcnt(0)" ::: "memory"); grid.sync(); if (wave0 == 0) asm volatile("buffer_inv sc1\n\ts_waitcnt vmcnt(0)" ::: "memory"); __syncthreads(); } while (0)
__global__ void __launch_bounds__(NTHREADS, 2) fwd_megakernel(Params p) {
    extern __shared__ __attribute__((aligned(16))) unsigned char lds_raw[];
    LAS unsigned char* lds = (LAS unsigned char*)lds_raw;
    cg::grid_group grid = cg::this_grid();
    const int bid0 = blockIdx.x, G0 = gridDim.x;
    const int wave0 = __builtin_amdgcn_readfirstlane(threadIdx.x >> 6);
#define TID_NOW() ({ unsigned _m = ~0u; asm volatile("" : "+s"(_m)); wave0 * 64 + (int)__builtin_amdgcn_mbcnt_hi(_m, __builtin_amdgcn_mbcnt_lo(_m, 0u)); })

    const unsigned myx = xcc_id();
    if (threadIdx.x == 0) bw_add((unsigned*)(gws() + WS_BAR) + BW_XCNT(myx), 1u);
    p0_init(lds, G0, bid0, TID_NOW());
    GRID_SYNC();
    unsigned nloc = 0u, nx = 0u;
    { unsigned* bar = (unsigned*)(gws() + WS_BAR);
      for (unsigned j = 0; j < 16; ++j) { const unsigned c = bw_ld(&bar[BW_XCNT(j)]); nx += (c > 0u) ? 1u : 0u; nloc = (j == myx) ? c : nloc; }
      nloc = __builtin_amdgcn_readfirstlane(nloc); nx = __builtin_amdgcn_readfirstlane(nx); }

    unsigned kb = 0u;
    constexpr int NSLOT = (DUP_SLOT >= 0) ? 9 : 8;
    for (int step = 0; step < DEPTH * NSLOT; ++step) {
        const int l = step / NSLOT, s9 = step - l * NSLOT, s = (DUP_SLOT >= 0 && s9 > DUP_SLOT) ? s9 - 1 : s9;
        int bid = bid0, G = G0; asm volatile("" : "+s"(bid), "+s"(G));
        unsigned char* ws = launder(gws());
        const bf16_t* hb = (const bf16_t*)(ws + WS_HB); const bf16_t* act = (const bf16_t*)(ws + WS_ACT);
        int tid = TID_NOW(); asm volatile("" : "+v"(tid));
        const int wave = wave0, lane = tid & 63;
        unsigned char* wl = ws + WS_W + (size_t)l * WL_SZ;
        int fin_ssn = -1, fin_ss5 = -1;
        if (EN(0) && (s == 0 || s == 6)) {
            pg8::Gemm g{hb, (const bf16_t*)(wl + (s == 0 ? WL_A1 : WL_A2)), D, D, D};
            pg8::Order S; S.init(MPAD / 256, FFN2 / 256, G, bid, 1, D, KREP_UP);
            EpiSwiglu E{ws, 3 * l + (s == 0 ? 0 : 2)};
            pg8::gemm_phase(lds, g, S, E, tid);
        } else if (EN(1) && (s == 1 || s == 7)) {
            pg8::Gemm g{act, (const bf16_t*)(wl + (s == 1 ? WL_D1 : WL_D2)), FFN, FFN, FFN};
            pg8::Order S; S.init(MPAD / 256, D / 256, G, bid, 1, FFN, 1, (G == 256) ? DOWN_SPLIT : 0);
            EpiRes E{ws, 3 * l + (s == 1 ? 1 : 3), -1, 0.5f};
            pg8::gemm_phase(lds, g, S, E, tid);
            if (S.nsplit > 0) { fin_ssn = 3 * l + (s == 1 ? 1 : 3); fin_ss5 = -1; }
        } else if (EN(2) && s == 2) {
            pg8::Gemm g{hb, (const bf16_t*)(wl + WL_IN), D, D, D};
            pg8::Order S; S.init(MPAD / 256, INC / 256, G, bid, 1, D);
            EpiWin E{ws, l};
            pg8::gemm_phase(lds, g, S, E, tid);
        } else if (EN(3) && s == 3) {
            {
                if (bid < 64) hgrn_prompt_item(l, bid >> 3, (bid >> 1) & 3, bid & 1, lds, tid, wave, lane);
                else { for (int it = bid - 64; it < 256; it += G - 64) s5_prompt_item(l, it >> 5, it & 31, lds, wave, lane); }
                if (bid >= 64) {
                    for (int it = bid - 64; it < 640; it += G - 64) {
                        if (it < 512) hgrn_sample_item(l, it >> 2, it & 3, wave, lane);
                        else { const int wi = (it - 512) * 8 + wave; s5_sample_wave(l, wi >> 5, wi & 31, lds, wave, lane); }
                    }
                }
            }
        } else if (EN(4) && s == 4) {
            {
                pg8::Gemm g{(const bf16_t*)(ws + WS_YG), (const bf16_t*)(wl + WL_GLU), 512, 512, 512};
                pg8::Order S; S.init(MPAD / 256, 2, G, bid, 1, 512);
                EpiGlu E{ws, l};
                pg8::gemm_phase(lds, g, S, E, tid);
            }
            const float* oraw = (const float*)(ws + WS_ORAW); const bf16_t* gs = (const bf16_t*)(ws + WS_GS); bf16_t* mixin = (bf16_t*)(ws + WS_MIXIN);
            for (int row = bid * 8 + wave; row < M; row += G * 8) {
                const int c = lane * 8;
                const f32x4 a = *(const f32x4*)(oraw + (size_t)row * 512 + c), b = *(const f32x4*)(oraw + (size_t)row * 512 + c + 4);
                float sq = a[0] * a[0] + a[1] * a[1] + a[2] * a[2] + a[3] * a[3] + b[0] * b[0] + b[1] * b[1] + b[2] * b[2] + b[3] * b[3];
                sq += __shfl_xor(sq, 1); sq += __shfl_xor(sq, 2); sq += __shfl_xor(sq, 4); sq += __shfl_xor(sq, 8);
                const float r = rsqrtf(sq * (1.f / 128.f) + EPS);
                const u32x4 gw = *(const u32x4*)(gs + (size_t)row * 512 + c);
                u32x4 w;
                w.x = pk_bf16(a[0] * r * bf16_lo(gw.x), a[1] * r * bf16_hi(gw.x)); w.y = pk_bf16(a[2] * r * bf16_lo(gw.y), a[3] * r * bf16_hi(gw.y));
                w.z = pk_bf16(b[0] * r * bf16_lo(gw.z), b[1] * r * bf16_hi(gw.z)); w.w = pk_bf16(b[2] * r * bf16_lo(gw.w), b[3] * r * bf16_hi(gw.w));
                *(u32x4*)(mixin + (size_t)row * 1024 + c) = w;
            }
        } else if (EN(5) && s == 5) {
            pg8::Gemm g{(const bf16_t*)(ws + WS_MIXIN), (const bf16_t*)(wl + WL_OUT), D, D, 512};
            pg8::Order S; S.init(MPAD / 256, D / 256, G, bid, 2, 512, 1, (G == 256) ? DOWN_SPLIT : 0);
            EpiRes E{ws, 3 * l + 2, 13 + l, 1.0f};
            pg8::gemm_phase(lds, g, S, E, tid);
            if (S.nsplit > 0) { fin_ssn = 3 * l + 2; fin_ss5 = 13 + l; }
        }
        if (fin_ssn >= 0) { fast_grid_barrier((unsigned*)(ws + WS_BAR), ++kb, myx, nloc, nx, tid); finish_remainder(ws, fin_ssn, fin_ss5, bid, G, wave, lane); }
        fast_grid_barrier((unsigned*)(ws + WS_BAR), ++kb, myx, nloc, nx, tid);
    }
    {
        int tidf = TID_NOW(); asm volatile("" : "+v"(tidf));
        const int bid = bid0, G = G0; unsigned char* ws = launder(gws());
        const int wave = wave0, lane = tidf & 63;
        const float* ssf = (const float*)(ws + WS_SS) + (size_t)12 * MPAD * 16; const float* nf = gin(30); const float* h32 = (const float*)(ws + WS_H32);
        for (int row = bid * 8 + wave; row < M; row += G * 8) {
            float* dst;
            if (row < MPROMPT) { const int b = row / LP, pos = row - b * LP; if (pos < 16) continue; dst = gout() + O_YP + ((size_t)b * SEQ + pos - 16) * D; }
            else dst = gout() + O_YS + (size_t)(row - MPROMPT) * D;
            const float rs = rsqrtf(row_ss16(ssf, row) * (1.f / 1024.f) + EPS);
#pragma unroll
            for (int i = 0; i < 4; ++i) {
                const int c = (i * 64 + lane) * 4;
                const f32x4 v = *(const f32x4*)(h32 + (size_t)row * D + c), gn = *(const f32x4*)(nf + c);
                *(f32x4*)(dst + c) = v * rs * gn;
            }
        }
    }
}

extern "C" void kernel_launch(void* const* d_in, const int* in_sizes, int n_in, void* d_out, int out_size, void* d_ws, size_t ws_size, hipStream_t stream) {
    static int grid_blocks = 0;
    if (grid_blocks == 0) {
        int dev = 0, cus = 0, per_cu = 0;
        hipGetDevice(&dev);
        hipDeviceGetAttribute(&cus, hipDeviceAttributeMultiprocessorCount, dev);
        hipFuncSetAttribute((const void*)fwd_megakernel, hipFuncAttributeMaxDynamicSharedMemorySize, LDS_BYTES);
        hipOccupancyMaxActiveBlocksPerMultiprocessor(&per_cu, (const void*)fwd_megakernel, NTHREADS, LDS_BYTES);
        if (per_cu < 1) per_cu = 1;
        grid_blocks = cus;
        if (ws_size < WS_END) { fprintf(stderr, "kernel_launch: workspace too small: %zu < %zu\n", ws_size, (size_t)WS_END); grid_blocks = -1; }
        if (n_in != 31) fprintf(stderr, "kernel_launch: expected 31 inputs, got %d\n", n_in);
    }
    if (grid_blocks < 0) return;
    Params p{};
    for (int i = 0; i < 31; ++i) p.in[i] = (const float*)d_in[i];
    p.out = (float*)d_out; p.ws = (unsigned char*)d_ws;
    hipMemsetAsync((char*)d_ws + WS_BAR, 0, 8192, stream);
    void* args[] = {&p};
    hipError_t e = hipLaunchCooperativeKernel((const void*)fwd_megakernel, dim3(grid_blocks), dim3(NTHREADS), args, LDS_BYTES, stream);
    if (e != hipSuccess) fprintf(stderr, "cooperative launch failed: %s (grid %d)\n", hipGetErrorString(e), grid_blocks);
}
```
